# Optimizing an MI355X kernel written in HIP

```python
import math
import jax, jax.numpy as jnp
from jax import lax
import numpy as np

D_MODEL = 2048
BATCH = 8
SEQ = 2048
DEPTH = 1

RNN_WIDTH = D_MODEL // 2
RNN_BLOCKS = 16
RNN_BLOCK_DIM = RNN_WIDTH // RNN_BLOCKS
CONV_WIDTH = 4
LRU_C = 8.0
N_HEADS = 8
HEAD_DIM = 128
ATTN_WIDTH = N_HEADS * HEAD_DIM
IDX_HEADS = 16
IDX_DIM = 64
INDEX_TOPK_MAX = 256
Q_BLOCK = 64
D_FF = 4 * D_MODEL
NORM_EPS = 1e-6
SPLITS = (RNN_WIDTH, RNN_WIDTH, ATTN_WIDTH, ATTN_WIDTH, ATTN_WIDTH,
          IDX_HEADS * IDX_DIM, IDX_DIM, IDX_HEADS, D_MODEL, D_MODEL)
D_IN = sum(SPLITS)
SPLIT_OFFSETS = tuple(int(o) for o in np.cumsum(SPLITS)[:-1])

kernel_name = 'hybrid_rglru_dsa_gated_block'


def rms_norm(x, g):
    xf = x.astype(jnp.float32)
    y = xf * lax.rsqrt(jnp.mean(xf * xf, axis=-1, keepdims=True) + NORM_EPS)
    return (y * g.astype(jnp.float32)).astype(x.dtype)


def causal_depthwise_conv(x, w, b):
    S = x.shape[1]
    xp = jnp.pad(x, ((0, 0), (CONV_WIDTH - 1, 0), (0, 0)))
    y = b
    for j in range(CONV_WIDTH):
        y = y + w[j] * xp[:, j:j + S]
    return y


def block_diag_linear(x, w, b):
    B, S, C = x.shape
    xb = x.reshape(B, S, RNN_BLOCKS, RNN_BLOCK_DIM)
    y = jnp.einsum('bsnd,nde->bsne', xb, w).reshape(B, S, C)
    return y + b


def rg_lru(x, w_r, b_r, w_i, b_i, lam):
    xf = x.astype(jnp.float32)
    r = jax.nn.sigmoid(block_diag_linear(xf, w_r.astype(jnp.float32), b_r.astype(jnp.float32)))
    i = jax.nn.sigmoid(block_diag_linear(xf, w_i.astype(jnp.float32), b_i.astype(jnp.float32)))
    log_a = -LRU_C * r * jax.nn.softplus(-lam.astype(jnp.float32))
    a = jnp.exp(log_a)
    mult = jnp.sqrt(-jnp.expm1(2.0 * log_a))
    u = mult * i * xf

    def combine(left, right):
        a1, b1 = left
        a2, b2 = right
        return a1 * a2, a2 * b1 + b2

    _, h = lax.associative_scan(combine, (a, u), axis=1)
    return h.astype(x.dtype)


def dsa_sparse_attention(q, k, v, iq, ik, iw, slopes):
    B, S = q.shape[0], q.shape[1]
    n_keys = S
    topk = min(INDEX_TOPK_MAX, n_keys // 4)
    n_blocks = S // Q_BLOCK
    key_pos = jnp.arange(S, dtype=jnp.int32)
    idx_scale = IDX_DIM ** -0.5
    w_scale = IDX_HEADS ** -0.5
    attn_scale = HEAD_DIM ** -0.5

    def one_block(blk):
        start = blk * Q_BLOCK
        qb = lax.dynamic_slice_in_dim(q, start, Q_BLOCK, axis=1)
        iqb = lax.dynamic_slice_in_dim(iq, start, Q_BLOCK, axis=1)
        iwb = lax.dynamic_slice_in_dim(iw, start, Q_BLOCK, axis=1)
        q_pos = start + jnp.arange(Q_BLOCK, dtype=jnp.int32)
        logits = jnp.einsum('bqhd,bsd->bqhs', iqb, ik).astype(jnp.float32) * idx_scale
        index_score = jnp.einsum('bqhs,bqh->bqs', jax.nn.relu(logits),
                                 iwb.astype(jnp.float32) * w_scale)
        causal = key_pos[None, :] <= q_pos[:, None]
        index_score = jnp.where(causal[None], index_score, -jnp.inf)
        _, sel = lax.top_k(index_score, topk)
        k_sel = jax.vmap(lambda kk, ii: kk[ii])(k, sel)
        v_sel = jax.vmap(lambda vv, ii: vv[ii])(v, sel)
        s = jnp.einsum('bqhd,bqkhd->bhqk', qb, k_sel).astype(jnp.float32) * attn_scale
        dist = (q_pos[None, :, None] - sel).astype(jnp.float32)
        s = s - slopes[None, :, None, None] * dist[:, None]
        valid = sel <= q_pos[None, :, None]
        s = jnp.where(valid[:, None], s, -jnp.inf)
        p = jax.nn.softmax(s, axis=-1).astype(v.dtype)
        o = jnp.einsum('bhqk,bqkhd->bqhd', p, v_sel)
        return o.reshape(B, Q_BLOCK, N_HEADS * HEAD_DIM)

    out = lax.map(one_block, jnp.arange(n_blocks, dtype=jnp.int32))
    return out.transpose(1, 0, 2, 3).reshape(B, S, N_HEADS * HEAD_DIM)


def setup_inputs(seed: int = 0) -> dict:
    key = jax.random.key(seed)
    ks = jax.random.split(key, 20)
    f32 = jnp.float32

    def nrm(k, shape, fan_in):
        return jax.random.normal(k, shape, f32) * (fan_in ** -0.5)

    x = jax.random.normal(ks[0], (BATCH, SEQ, D_MODEL), f32)
    norm_mix_g = 1.0 + 0.02 * jax.random.normal(ks[1], (DEPTH, D_MODEL), f32)
    w_in = nrm(ks[2], (DEPTH, D_MODEL, D_IN), D_MODEL)
    conv_w = nrm(ks[3], (DEPTH, CONV_WIDTH, RNN_WIDTH), CONV_WIDTH)
    conv_b = 0.02 * jax.random.normal(ks[4], (DEPTH, RNN_WIDTH), f32)
    w_rg_r = nrm(ks[5], (DEPTH, RNN_BLOCKS, RNN_BLOCK_DIM, RNN_BLOCK_DIM), RNN_BLOCK_DIM)
    b_rg_r = 0.02 * jax.random.normal(ks[6], (DEPTH, RNN_WIDTH), f32)
    w_rg_i = nrm(ks[7], (DEPTH, RNN_BLOCKS, RNN_BLOCK_DIM, RNN_BLOCK_DIM), RNN_BLOCK_DIM)
    b_rg_i = 0.02 * jax.random.normal(ks[8], (DEPTH, RNN_WIDTH), f32)
    u = jax.random.uniform(ks[9], (DEPTH, RNN_WIDTH), f32, 0.9, 0.999)
    a0 = u ** (1.0 / LRU_C)
    lru_lambda = jnp.log(a0) - jnp.log1p(-a0)
    w_branch_rnn = nrm(ks[10], (DEPTH, RNN_WIDTH, D_MODEL), RNN_WIDTH)
    w_branch_attn = nrm(ks[11], (DEPTH, ATTN_WIDTH, D_MODEL), ATTN_WIDTH)
    w_out = nrm(ks[12], (DEPTH, D_MODEL, D_MODEL), D_MODEL)
    norm_mlp_g = 1.0 + 0.02 * jax.random.normal(ks[13], (DEPTH, D_MODEL), f32)
    w_mlp_up = nrm(ks[14], (DEPTH, D_MODEL, D_FF), D_MODEL)
    w_mlp_down = nrm(ks[15], (DEPTH, D_FF, D_MODEL), D_FF)
    norm_final_g = 1.0 + 0.02 * jax.random.normal(ks[16], (D_MODEL,), f32)
    return {'x': x, 'norm_mix_g': norm_mix_g, 'w_in': w_in, 'conv_w': conv_w,
            'conv_b': conv_b, 'w_rg_r': w_rg_r, 'b_rg_r': b_rg_r, 'w_rg_i': w_rg_i,
            'b_rg_i': b_rg_i, 'lru_lambda': lru_lambda, 'w_branch_rnn': w_branch_rnn,
            'w_branch_attn': w_branch_attn, 'w_out': w_out, 'norm_mlp_g': norm_mlp_g,
            'w_mlp_up': w_mlp_up, 'w_mlp_down': w_mlp_down, 'norm_final_g': norm_final_g}


def reference(x, norm_mix_g, w_in, conv_w, conv_b, w_rg_r, b_rg_r, w_rg_i, b_rg_i,
              lru_lambda, w_branch_rnn, w_branch_attn, w_out, norm_mlp_g,
              w_mlp_up, w_mlp_down, norm_final_g):
    B, S, _ = x.shape
    slopes = 2.0 ** (-8.0 * jnp.arange(1, N_HEADS + 1, dtype=jnp.float32) / N_HEADS)
    h = x
    for l in range(DEPTH):
        u = rms_norm(h, norm_mix_g[l])
        proj = u @ w_in[l]
        (rx, rgate, q, k, v, iq, ik, iw, gate_a, gate_b) = jnp.split(proj, SPLIT_OFFSETS, axis=-1)
        xc = causal_depthwise_conv(rx, conv_w[l], conv_b[l])
        ya = rg_lru(xc, w_rg_r[l], b_rg_r[l], w_rg_i[l], b_rg_i[l], lru_lambda[l]) * jax.nn.gelu(rgate)
        yb = dsa_sparse_attention(q.reshape(B, S, N_HEADS, HEAD_DIM),
                                  k.reshape(B, S, N_HEADS, HEAD_DIM),
                                  v.reshape(B, S, N_HEADS, HEAD_DIM),
                                  iq.reshape(B, S, IDX_HEADS, IDX_DIM), ik, iw, slopes)
        mixed = (jax.nn.sigmoid(gate_a) * (ya @ w_branch_rnn[l])
                 + jax.nn.sigmoid(gate_b) * (yb @ w_branch_attn[l]))
        h = h + mixed @ w_out[l]
        u = rms_norm(h, norm_mlp_g[l])
        h = h + jnp.square(jax.nn.relu(u @ w_mlp_up[l])) @ w_mlp_down[l]
    return rms_norm(h, norm_final_g)
```

```cpp
#include <hip/hip_runtime.h>
#include <cstdio>
#include <cstdint>

#ifndef MK_N_LAUNCHES
#define MK_N_LAUNCHES 1
#endif
#ifndef LATE_TRANSPOSE
#define LATE_TRANSPOSE 0
#endif
#ifndef PROBE_DUP
#define PROBE_DUP (-1)
#endif

#define GAS __attribute__((address_space(1)))
#define LAS __attribute__((address_space(3)))
typedef unsigned short bf16;
typedef short bf16x8 __attribute__((ext_vector_type(8)));
typedef short s16x4 __attribute__((ext_vector_type(4)));
typedef float f32x4 __attribute__((ext_vector_type(4)));
typedef float f32x2 __attribute__((ext_vector_type(2)));
typedef float f32x16 __attribute__((ext_vector_type(16)));
typedef unsigned u32x4 __attribute__((ext_vector_type(4)));
typedef unsigned u32x2 __attribute__((ext_vector_type(2)));
typedef GAS unsigned gu32;
typedef int i32x4 __attribute__((ext_vector_type(4)));
typedef int i32x8 __attribute__((ext_vector_type(8)));

constexpr int NWAVES = 8;
constexpr int BATCH = 8, SEQ = 2048, M = BATCH * SEQ, D = 2048, DFF = 8192;
constexpr int NPROJ = 10496;
constexpr float NORM_EPS = 1e-6f;
constexpr float LOG2E = 1.4426950408889634f;
constexpr float QSCALE = 0.08838834764831845f * LOG2E;
constexpr int NPHASE = 9;

constexpr size_t MiB = 1u << 20;
constexpr size_t WS_CTL = 0, CTL_ZERO_BYTES = 1 * MiB;
constexpr size_t WS_WIN = 2 * MiB;
constexpr size_t WS_WBR = 43 * MiB;
constexpr size_t WS_WO = 51 * MiB;
constexpr size_t WS_WUP = 59 * MiB;
constexpr size_t WS_WDN = 91 * MiB;
constexpr size_t WS_WRT = 123 * MiB;
constexpr size_t WS_MASK = 124 * MiB;
constexpr size_t WS_PA = 128 * MiB;
constexpr size_t WS_QKV = 192 * MiB;
constexpr size_t WS_IQ = 288 * MiB;
constexpr size_t WS_IKW = 320 * MiB;
constexpr size_t WS_GATES = 328 * MiB;
constexpr size_t WS_END = 456 * MiB;
constexpr size_t WS_H1 = 328 * MiB;
constexpr size_t WS_H2 = 392 * MiB;
constexpr size_t WS_MIXED = WS_QKV;
constexpr size_t WS_TMP = 256 * MiB;
constexpr size_t WS_A2 = WS_PA;
constexpr size_t WS_ACT = WS_QKV;
constexpr int CW_BAR = 4096;
constexpr int CW_LATEQ = 16384 + 1024;
constexpr int CW_IDXQ = 16384;
constexpr int CW_SSQ1 = 32768;
constexpr int CW_SSQ2 = 32768 + 16384;
static_assert((CW_SSQ2 + 16384) * 4 <= (int)CTL_ZERO_BYTES, "ctl");

constexpr int LDS_BYTES = 147456;
constexpr int RING_BYTES = 131072;
constexpr int MISC_OFF = RING_BYTES + 320;

__device__ __forceinline__ unsigned cvt_pk_bf16(float lo, float hi) { unsigned r; asm volatile("v_cvt_pk_bf16_f32 %0, %1, %2" : "=v"(r) : "v"(lo), "v"(hi)); return r; }
__device__ __forceinline__ unsigned pk4_fp8(float a, float b, float c, float d) { int w = 0; w = __builtin_amdgcn_cvt_pk_fp8_f32(a, b, w, false); w = __builtin_amdgcn_cvt_pk_fp8_f32(c, d, w, true); return (unsigned)w; }
constexpr float WUP_SCALE = 64.f, WDN_SCALE = 128.f, WIN_SCALE = 64.f, WBR_SCALE = 32.f, WO_SCALE = 64.f;
__device__ __forceinline__ unsigned char f2fp8(float a) { return (unsigned char)(__builtin_amdgcn_cvt_pk_fp8_f32(a, a, 0, false) & 0xff); }
__device__ __forceinline__ float bflo(unsigned w) { return __uint_as_float(w << 16); }
__device__ __forceinline__ float bfhi(unsigned w) { return __uint_as_float(w & 0xffff0000u); }
__device__ __forceinline__ float bf2f(bf16 b) { return __uint_as_float(((unsigned)b) << 16); }
__device__ __forceinline__ float fast_sigmoid(float x) { return __builtin_amdgcn_rcpf(1.0f + __builtin_amdgcn_exp2f(-LOG2E * x)); }
__device__ __forceinline__ float gelu_tanh(float x) { const float u = x + 0.044715f * x * x * x; return x * __builtin_amdgcn_rcpf(1.0f + __builtin_amdgcn_exp2f(-2.0f * 0.7978845608f * LOG2E * u)); }
__device__ __forceinline__ int crow(int r, int hi) { return (r & 3) + 8 * (r >> 2) + 4 * hi; }

namespace pg8 {
constexpr int BM = 256, BK = 64, HALF = 128, HTB = HALF * BK * 2, STAGE_BYTES = 8 * HTB, NXCD = 8, WGM = 8;
__host__ __device__ __forceinline__ int lds_byte(int r, int c) { const int st = (r >> 4) * 2 + (c >> 5), rr = r & 15, cc = c & 31, ob = rr * 64 + cc * 2; return st * 1024 + (ob ^ (((ob >> 9) & 1) << 5)); }
__host__ __device__ __forceinline__ void stage_rc(int b, int& R, int& C) { const int st = b / 1024, sb = b % 1024, swz = sb ^ (((sb >> 9) & 1) << 5); R = (st >> 1) * 16 + swz / 64; C = (st & 1) * 32 + (swz % 64) / 2; }
__host__ __device__ __forceinline__ int perm32(int rho) { const int n = rho >> 4, i = rho & 15; return 8 * (i >> 2) + 4 * n + (i & 3); }

struct Unit { int pm, pn, kh; };
struct Gemm { const void* A; const void* Bt; int Kb, lda, ldb; };

struct StaticOrder {
    int nM, nN, nwg, G, c;
    __device__ void init(int M_, int N_, int G_, int c_) { nM = M_ / BM; nN = N_ / BM; nwg = nM * nN; G = G_; c = c_; }
    __device__ bool next(int i, Unit& u) const {
        const long L = (long)i * G + c; if (L >= nwg) return false;
        int wgid = (int)L; { const int q = nwg / NXCD, r = nwg % NXCD, xcd = wgid % NXCD, off = wgid / NXCD; wgid = (xcd < r ? xcd * (q + 1) : r * (q + 1) + (xcd - r) * q) + off; }
        const int nig = WGM * nN, gid = wgid / nig, fm = gid * WGM, gsz = (nM - fm) < WGM ? (nM - fm) : WGM;
        u.pm = fm + ((wgid % nig) % gsz); u.pn = (wgid % nig) / gsz; u.kh = 0; return true;
    }
};
struct InprojOrder {
    StaticOrder S;
    __device__ bool next(int i, Unit& u) const {
        long L;
        if (i < 7) L = (long)i * 256 + S.c;
        else { if (S.c < 64) return false; const int e = (S.c - 64) + 192 * (i - 7); if (e >= 512) return false; L = 1792 + e; }
        int wgid = (int)L; { const int q = S.nwg / NXCD, r = S.nwg % NXCD, xcd = wgid % NXCD, off = wgid / NXCD; wgid = (xcd < r ? xcd * (q + 1) : r * (q + 1) + (xcd - r) * q) + off; }
        const int nig = WGM * S.nN, gid = wgid / nig, fm = gid * WGM, gsz = (S.nM - fm) < WGM ? (S.nM - fm) : WGM;
        u.pm = fm + ((wgid % nig) % gsz); u.pn = (wgid % nig) / gsz; u.kh = 0; return true;
    }
};
struct PairOrder {
    StaticOrder S;
    __device__ bool next(int i, Unit& u) const { if (!S.next(i >> 1, u)) return false; u.kh = i & 1; return true; }
};

template <class Epi, class Sched, bool FP8 = false>
__device__ __forceinline__ void gemm_phase(LAS unsigned char* lds, const Gemm g, const Sched& S, const Epi& E) {
    const int tid = threadIdx.x, wid = __builtin_amdgcn_readfirstlane(tid >> 6), lane = tid & 63, wr = wid >> 2, wc = wid & 3, fr = lane & 15, fq = lane >> 4;
    const int nt = g.Kb / (BK * 2);
    unsigned voffA[2], voffB[2];
#pragma unroll
    for (int i = 0; i < 2; ++i) { int R, C; stage_rc(tid * 16 + i * 8192, R, C); const int Rb = Epi::PERM ? ((R & ~31) + perm32(R & 31)) : R;
        voffA[i] = (unsigned)(R * g.lda + C * 2); voffB[i] = (unsigned)(Rb * g.ldb + C * 2); }
    const size_t kstep = (size_t)(BK * 2);
    const size_t hstepA = (size_t)HALF * g.lda, hstepB = (size_t)HALF * g.ldb;
    const size_t tstepA = 2 * hstepA, tstepB = 2 * hstepB, koff = (size_t)g.Kb;
    const unsigned ldsw = (unsigned)wid * 1024u;
    const int aoff = lds_byte(wr * 64 + fr, fq * 8), boff = lds_byte(wc * 32 + fr, fq * 8);
#define PG8_SA(b, h) (((b) * 2 + (h)) * HTB)
#define PG8_SB(b, h) ((4 + (b) * 2 + (h)) * HTB)
#define PG8_STAGE(bufoff, gbase, voff) do { _Pragma("unroll") for (int _i = 0; _i < 2; ++_i) \
        __builtin_amdgcn_global_load_lds((const unsigned*)((const char*)(gbase) + (voff)[_i]), (LAS unsigned*)(lds + (bufoff) + ldsw + _i * 8192), 16, 0, 0); } while (0)
#define PG8_LDA(dst, b, h) do { _Pragma("unroll") for (int m = 0; m < 4; ++m) { const i32x4 lo_ = *(const LAS i32x4*)(lds + PG8_SA(b, h) + aoff + m * 2048), hi_ = *(const LAS i32x4*)(lds + PG8_SA(b, h) + aoff + m * 2048 + 1024); \
        dst[m] = __builtin_shufflevector(lo_, hi_, 0, 1, 2, 3, 4, 5, 6, 7); } } while (0)
#define PG8_LDB(dst, b, h) do { _Pragma("unroll") for (int n = 0; n < 2; ++n) { const i32x4 lo_ = *(const LAS i32x4*)(lds + PG8_SB(b, h) + boff + n * 2048), hi_ = *(const LAS i32x4*)(lds + PG8_SB(b, h) + boff + n * 2048 + 1024); \
        dst[n] = __builtin_shufflevector(lo_, hi_, 0, 1, 2, 3, 4, 5, 6, 7); } } while (0)
#define PG8_MMA(ai, bj, At, Bt) do { __builtin_amdgcn_s_setprio(1); _Pragma("unroll") for (int m = 0; m < 4; ++m) _Pragma("unroll") for (int n = 0; n < 2; ++n) { \
        if constexpr (FP8) asm volatile("v_mfma_scale_f32_16x16x128_f8f6f4 %0, %1, %2, %0, %3, %3 op_sel_hi:[0,0,0]" : "+v"(acc[ai][bj][m][n]) : "v"(Bt[n]), "v"(At[m]), "v"(sc7f)); \
        else { acc[ai][bj][m][n] = __builtin_amdgcn_mfma_f32_16x16x32_bf16(__builtin_bit_cast(bf16x8, __builtin_shufflevector(Bt[n], Bt[n], 0, 1, 2, 3)), __builtin_bit_cast(bf16x8, __builtin_shufflevector(At[m], At[m], 0, 1, 2, 3)), acc[ai][bj][m][n], 0, 0, 0); \
               acc[ai][bj][m][n] = __builtin_amdgcn_mfma_f32_16x16x32_bf16(__builtin_bit_cast(bf16x8, __builtin_shufflevector(Bt[n], Bt[n], 4, 5, 6, 7)), __builtin_bit_cast(bf16x8, __builtin_shufflevector(At[m], At[m], 4, 5, 6, 7)), acc[ai][bj][m][n], 0, 0, 0); } } \
        __builtin_amdgcn_s_setprio(0); } while (0)
#define PG8_WAIT_V(n) asm volatile("s_waitcnt vmcnt(" #n ")" ::: "memory")
#define PG8_WAIT_L(n) asm volatile("s_waitcnt lgkmcnt(" #n ")" ::: "memory")
#define PG8_BAR __builtin_amdgcn_s_barrier()
#define PG8_SCHED __builtin_amdgcn_sched_barrier(0)
    Unit cur, nxt; int ui = 0;
    if (!S.next(0, cur)) return;
    f32x4 acc[2][2][4][2];
#pragma unroll
    for (int a = 0; a < 2; ++a)
#pragma unroll
        for (int b = 0; b < 2; ++b)
#pragma unroll
            for (int m = 0; m < 4; ++m)
#pragma unroll
                for (int n = 0; n < 2; ++n) acc[a][b][m][n] = (f32x4){0.f, 0.f, 0.f, 0.f};
    i32x8 At[4], B0[2], B1[2];
    const int sc7f = 0x7F7F7F7F;
    const char* cA = (const char*)g.A + (size_t)cur.pm * tstepA + (size_t)cur.kh * koff; const char* cB = (const char*)g.Bt + (size_t)cur.pn * tstepB + (size_t)cur.kh * koff;
    PG8_STAGE(PG8_SB(0, 0), cB, voffB); PG8_STAGE(PG8_SB(0, 1), cB + hstepB, voffB); PG8_STAGE(PG8_SA(0, 0), cA, voffA); PG8_STAGE(PG8_SA(0, 1), cA + hstepA, voffA);
    if (wr == 1) PG8_BAR;
    PG8_WAIT_V(2); PG8_BAR;
    PG8_STAGE(PG8_SB(1, 0), cB + kstep, voffB); PG8_STAGE(PG8_SA(1, 0), cA + kstep, voffA); PG8_STAGE(PG8_SB(1, 1), cB + hstepB + kstep, voffB);
    PG8_WAIT_V(6); PG8_BAR;
    for (;;) {
        const bool has_next = S.next(ui + 1, nxt);
        const char* nA = has_next ? (const char*)g.A + (size_t)nxt.pm * tstepA + (size_t)nxt.kh * koff : cA; const char* nB = has_next ? (const char*)g.Bt + (size_t)nxt.pn * tstepB + (size_t)nxt.kh * koff : cB;
        for (int t = 0; t < nt; t += 2) {
            const bool last = (t == nt - 2);
            const char* a1 = cA + (size_t)(t + 1) * kstep;
            const char* a2 = last ? nA : cA + (size_t)(t + 2) * kstep; const char* b2 = last ? nB : cB + (size_t)(t + 2) * kstep;
            const char* a3 = a2 + kstep; const char* b3 = b2 + kstep;
            PG8_LDB(B0, 0, 0); PG8_LDB(B1, 0, 1); PG8_SCHED; PG8_LDA(At, 0, 0); PG8_STAGE(PG8_SA(1, 1), a1 + hstepA, voffA);
            PG8_WAIT_V(8); PG8_WAIT_L(0); PG8_BAR; PG8_MMA(0, 0, At, B0); PG8_MMA(0, 1, At, B1); PG8_BAR; PG8_SCHED;
            PG8_LDA(At, 0, 1); PG8_STAGE(PG8_SB(0, 0), b2, voffB); PG8_STAGE(PG8_SB(0, 1), b2 + hstepB, voffB); PG8_STAGE(PG8_SA(0, 0), a2, voffA);
            PG8_WAIT_V(8); PG8_WAIT_L(0); PG8_BAR; PG8_MMA(1, 0, At, B0); PG8_MMA(1, 1, At, B1); PG8_BAR; PG8_SCHED;
            PG8_LDB(B0, 1, 0); PG8_LDB(B1, 1, 1); PG8_SCHED; PG8_LDA(At, 1, 0); PG8_STAGE(PG8_SA(0, 1), a2 + hstepA, voffA);
            PG8_WAIT_V(8); PG8_WAIT_L(0); PG8_BAR; PG8_MMA(0, 0, At, B0); PG8_MMA(0, 1, At, B1); PG8_BAR; PG8_SCHED;
            PG8_LDA(At, 1, 1); PG8_STAGE(PG8_SB(1, 0), b3, voffB); PG8_STAGE(PG8_SB(1, 1), b3 + hstepB, voffB); PG8_STAGE(PG8_SA(1, 0), a3, voffA);
            PG8_WAIT_V(8); PG8_WAIT_L(0); PG8_BAR; PG8_MMA(1, 0, At, B0); PG8_MMA(1, 1, At, B1); PG8_BAR; PG8_SCHED;
        }
        if (wr == 0) PG8_BAR;
        if constexpr (FP8) asm volatile("s_nop 15\n\ts_nop 15" ::: "memory");
        E(acc, cur, wr, wc, fr, fq);
        if (!has_next) break;
#pragma unroll
        for (int a = 0; a < 2; ++a)
#pragma unroll
            for (int b = 0; b < 2; ++b)
#pragma unroll
                for (int m = 0; m < 4; ++m)
#pragma unroll
                    for (int n = 0; n < 2; ++n) acc[a][b][m][n] = (f32x4){0.f, 0.f, 0.f, 0.f};
        cur = nxt; cA = nA; cB = nB; ++ui;
        if (wr == 1) PG8_BAR;
    }
    PG8_WAIT_V(0);
    PG8_BAR;
#undef PG8_SA
#undef PG8_SB
#undef PG8_STAGE
#undef PG8_LDA
#undef PG8_LDB
#undef PG8_MMA
#undef PG8_WAIT_V
#undef PG8_WAIT_L
#undef PG8_BAR
#undef PG8_SCHED
}
}

template <int MODE> struct EpiProj {
    static constexpr bool PERM = true;
    bf16 *PA, *QKV, *IQ, *IK, *IW, *GATES;
    __device__ __forceinline__ void operator()(const f32x4 (&acc)[2][2][4][2], const pg8::Unit& u, int wr, int wc, int fr, int fq) const {
        const int pn = (MODE == 0) ? (u.pn < 20 ? u.pn : u.pn + 4) : (u.pn < 4 ? 20 + u.pn : 40);
        const float asc = (MODE == 0) ? (1.0f / WIN_SCALE) : 1.0f;
        const int row0 = u.pm * 256 + wr * 64 + fr;
        if (MODE == 1 && pn == 40) {
            if (wc < 2 || (wc == 2 && fq < 2)) {
                bf16* dst = (wc < 2) ? IK + (size_t)row0 * 64 + wc * 32 + 8 * fq : IW + (size_t)row0 * 16 + 8 * fq; const int ld = (wc < 2) ? 64 : 16;
#pragma unroll
                for (int ai = 0; ai < 2; ++ai)
#pragma unroll
                    for (int m = 0; m < 4; ++m) { const f32x4 v0 = acc[ai][0][m][0], v1 = acc[ai][0][m][1];
                        u32x4 w; w.x = cvt_pk_bf16(v0[0], v0[1]); w.y = cvt_pk_bf16(v0[2], v0[3]); w.z = cvt_pk_bf16(v1[0], v1[1]); w.w = cvt_pk_bf16(v1[2], v1[3]);
                        *(u32x4*)(dst + (size_t)(ai * 128 + m * 16) * ld) = w; }
            }
            return;
        }
        bf16* base; int ldc, cofs, act;
        if (pn < 4)       { base = PA;    ldc = 2048; cofs = pn * 256;               act = 0; }
        else if (pn < 8)  { base = PA;    ldc = 2048; cofs = 1024 + (pn - 4) * 256;  act = 1; }
        else if (pn < 12) { base = QKV;   ldc = 3072; cofs = (pn - 8) * 256;         act = 3; }
        else if (pn < 20) { base = QKV;   ldc = 3072; cofs = 1024 + (pn - 12) * 256; act = 0; }
        else if (pn < 24) { base = IQ;    ldc = 1024; cofs = (pn - 20) * 256;        act = 0; }
        else              { base = GATES; ldc = 4096; cofs = (pn - 24) * 256;        act = 2; }
        const int col0 = cofs + wc * 32 + 8 * fq;
#pragma unroll
        for (int ai = 0; ai < 2; ++ai)
#pragma unroll
            for (int m = 0; m < 4; ++m) { bf16* rowp = base + (size_t)(row0 + ai * 128 + m * 16) * ldc + col0;
#pragma unroll
                for (int bj = 0; bj < 2; ++bj) { f32x4 v0 = acc[ai][bj][m][0] * asc, v1 = acc[ai][bj][m][1] * asc;
                    if (act == 1) {
#pragma unroll
                        for (int j = 0; j < 4; ++j) { v0[j] = gelu_tanh(v0[j]); v1[j] = gelu_tanh(v1[j]); } }
                    else if (act == 2) {
#pragma unroll
                        for (int j = 0; j < 4; ++j) { v0[j] = fast_sigmoid(v0[j]); v1[j] = fast_sigmoid(v1[j]); } }
                    else if (act == 3) { v0 = v0 * QSCALE; v1 = v1 * QSCALE; }
                    u32x4 w; w.x = cvt_pk_bf16(v0[0], v0[1]); w.y = cvt_pk_bf16(v0[2], v0[3]); w.z = cvt_pk_bf16(v1[0], v1[1]); w.w = cvt_pk_bf16(v1[2], v1[3]);
                    *(u32x4*)(rowp + bj * 128) = w; } }
    }
};
struct EpiBranch {
    static constexpr bool PERM = true;
    const bf16* GATES; unsigned char* MIXED; float* TMPW;
    __device__ __forceinline__ void operator()(const f32x4 (&acc)[2][2][4][2], const pg8::Unit& u, int wr, int wc, int fr, int fq) const {
        const int row0 = u.pm * 256 + wr * 64 + fr, col0 = u.pn * 256 + wc * 32 + 8 * fq;
        float* tbase = TMPW + (size_t)threadIdx.x * 128;
        const bf16* gbase = GATES + (u.kh ? 2048 : 0) + col0;
#pragma unroll
        for (int ai = 0; ai < 2; ++ai)
#pragma unroll
        for (int mh = 0; mh < 2; ++mh) {
            u32x4 gw[2][2];
#pragma unroll
            for (int mm = 0; mm < 2; ++mm)
#pragma unroll
                for (int bj = 0; bj < 2; ++bj) gw[mm][bj] = *(const u32x4*)(gbase + (size_t)(row0 + ai * 128 + (2 * mh + mm) * 16) * 4096 + bj * 128);
            if (u.kh == 0) {
#pragma unroll
                for (int mm = 0; mm < 2; ++mm)
#pragma unroll
                    for (int bj = 0; bj < 2; ++bj) { const int m = 2 * mh + mm; const u32x4 g = gw[mm][bj];
                        const f32x4 g0 = {bflo(g.x), bfhi(g.x), bflo(g.y), bfhi(g.y)}, g1 = {bflo(g.z), bfhi(g.z), bflo(g.w), bfhi(g.w)};
                        float* tp = tbase + ((ai * 4 + m) * 2 + bj) * 8;
                        *(f32x4*)tp = acc[ai][bj][m][0] * g0; *(f32x4*)(tp + 4) = acc[ai][bj][m][1] * g1; }
            } else {
                f32x4 tv[2][2][2];
#pragma unroll
                for (int mm = 0; mm < 2; ++mm)
#pragma unroll
                    for (int bj = 0; bj < 2; ++bj) { const float* tp = tbase + ((ai * 4 + 2 * mh + mm) * 2 + bj) * 8; tv[mm][bj][0] = *(const f32x4*)tp; tv[mm][bj][1] = *(const f32x4*)(tp + 4); }
#pragma unroll
                for (int mm = 0; mm < 2; ++mm)
#pragma unroll
                    for (int bj = 0; bj < 2; ++bj) { const int m = 2 * mh + mm; const u32x4 g = gw[mm][bj];
                        const f32x4 g0 = {bflo(g.x), bfhi(g.x), bflo(g.y), bfhi(g.y)}, g1 = {bflo(g.z), bfhi(g.z), bflo(g.w), bfhi(g.w)};
                        const f32x4 v0 = (acc[ai][bj][m][0] * g0 + tv[mm][bj][0]) * (1.0f / WBR_SCALE), v1 = (acc[ai][bj][m][1] * g1 + tv[mm][bj][1]) * (1.0f / WBR_SCALE);
                        u32x2 w; w.x = pk4_fp8(v0[0], v0[1], v0[2], v0[3]); w.y = pk4_fp8(v1[0], v1[1], v1[2], v1[3]);
                        *(u32x2*)(MIXED + (size_t)(row0 + ai * 128 + m * 16) * 2048 + col0 + bj * 128) = w; }
            }
            asm volatile("" ::: "memory");
        }
    }
};
template <bool WRITE_A2, bool HIN_BF16> struct EpiResid {
    static constexpr bool PERM = false;
    const void* hin; bf16* hout; unsigned char* A2; float* ssq; float accscale;
    __device__ __forceinline__ void operator()(const f32x4 (&acc)[2][2][4][2], const pg8::Unit& u, int wr, int wc, int fr, int fq) const {
        const int row0 = u.pm * 256 + wr * 64 + fr, col0 = u.pn * 256 + wc * 32 + 4 * fq;
#pragma unroll
        for (int ai = 0; ai < 2; ++ai)
#pragma unroll
            for (int m = 0; m < 4; ++m) { const int row = row0 + ai * 128 + m * 16; const size_t off = (size_t)row * 2048 + col0; float s = 0.f;
#pragma unroll
                for (int bj = 0; bj < 2; ++bj)
#pragma unroll
                    for (int n = 0; n < 2; ++n) { const size_t o = off + bj * 128 + n * 16; f32x4 hv;
                        if (HIN_BF16) { const u32x2 w = *(const u32x2*)((const bf16*)hin + o); hv = (f32x4){bflo(w.x), bfhi(w.x), bflo(w.y), bfhi(w.y)}; }
                        else hv = *(const f32x4*)((const float*)hin + o);
                        const f32x4 h = hv + acc[ai][bj][m][n] * accscale;
                        u32x2 ow; ow.x = cvt_pk_bf16(h[0], h[1]); ow.y = cvt_pk_bf16(h[2], h[3]); *(u32x2*)(hout + o) = ow;
                        s += (h[0] * h[0] + h[1] * h[1]) + (h[2] * h[2] + h[3] * h[3]);
                        if (WRITE_A2) *(unsigned*)(A2 + o) = pk4_fp8(h[0], h[1], h[2], h[3]); }
                s += __shfl_xor(s, 16); s += __shfl_xor(s, 32);
                if (fq == 0) atomicAdd(ssq + row, s); }
    }
};
struct EpiUp {
    static constexpr bool PERM = true;
    const float* ssq; unsigned char* ACT;
    __device__ __forceinline__ void operator()(const f32x4 (&acc)[2][2][4][2], const pg8::Unit& u, int wr, int wc, int fr, int fq) const {
        const int row0 = u.pm * 256 + wr * 64 + fr, col0 = u.pn * 256 + wc * 32 + 8 * fq;
        float rs[8];
#pragma unroll
        for (int i = 0; i < 8; ++i) rs[i] = __hip_atomic_load(ssq + row0 + (i >> 2) * 128 + (i & 3) * 16, __ATOMIC_RELAXED, __HIP_MEMORY_SCOPE_AGENT);
#pragma unroll
        for (int ai = 0; ai < 2; ++ai)
#pragma unroll
            for (int m = 0; m < 4; ++m) { const int row = row0 + ai * 128 + m * 16;
                const float rstd = __builtin_amdgcn_rsqf(rs[ai * 4 + m] * (1.0f / 2048.0f) + NORM_EPS) * (1.0f / WUP_SCALE);
                unsigned char* rowp = ACT + (size_t)row * 8192 + col0;
#pragma unroll
                for (int bj = 0; bj < 2; ++bj) { f32x4 v0 = acc[ai][bj][m][0] * rstd, v1 = acc[ai][bj][m][1] * rstd;
#pragma unroll
                    for (int j = 0; j < 4; ++j) { const float a = fmaxf(v0[j], 0.f), b = fmaxf(v1[j], 0.f); v0[j] = fminf(a * a, 448.f); v1[j] = fminf(b * b, 448.f); }
                    u32x2 w; w.x = pk4_fp8(v0[0], v0[1], v0[2], v0[3]); w.y = pk4_fp8(v1[0], v1[1], v1[2], v1[3]);
                    *(u32x2*)(rowp + bj * 128) = w; } }
    }
};

#define XB_TMO      128
#define XB_XCNT(j)  (256  + 64 * (j))
#define XB_XSUB(j)  (1280 + 64 * (j))
#define XB_XGEN(j)  (2304 + 64 * (j))
#define XB_TOP      3328
#define XB_TOPGEN   3392
#define XCD_BAR_WORDS 3456
#define XB_SPIN_CAP (1u << 18)
__device__ __forceinline__ unsigned xb_ld(unsigned* p)              { return __hip_atomic_load(p, __ATOMIC_RELAXED, __HIP_MEMORY_SCOPE_AGENT); }
__device__ __forceinline__ unsigned xb_add(unsigned* p, unsigned v) { return __hip_atomic_fetch_add(p, v, __ATOMIC_RELAXED, __HIP_MEMORY_SCOPE_AGENT); }
__device__ __forceinline__ unsigned xb_xcc_id() { return (unsigned)__builtin_amdgcn_s_getreg((3 << 11) | 20) & 0xFu; }
#define XB_SPIN(cond, bar) do { unsigned _sp = 0; while (cond) { __builtin_amdgcn_s_sleep(1); \
    if ((++_sp & 255u) == 0u) { if (xb_ld(&(bar)[XB_TMO])) break; if (_sp > XB_SPIN_CAP) { atomicAdd(&(bar)[XB_TMO], 1u); break; } } } } while (0)
struct XcdBarrier { unsigned* bar; unsigned x; volatile LAS unsigned* st; };
__device__ __forceinline__ XcdBarrier xcd_barrier_post(unsigned* bar, volatile LAS unsigned* st) {
    XcdBarrier b; b.bar = bar; b.x = xb_xcc_id(); b.st = st;
    if (threadIdx.x == 0) (void)xb_add(&bar[XB_XCNT(b.x)], 1u);
    return b;
}
__device__ __forceinline__ void xcd_barrier_complete(unsigned* bar, unsigned x, unsigned& nloc, unsigned& nx) {
    const unsigned G = gridDim.x * gridDim.y * gridDim.z;
    unsigned sum, cnt, mine, sp = 0u;
    for (;;) {
        sum = 0u; cnt = 0u; mine = 0u;
#pragma unroll
        for (unsigned j = 0; j < 16; ++j) { const unsigned c = xb_ld(&bar[XB_XCNT(j)]); sum += c; cnt += (c > 0u) ? 1u : 0u; mine = (j == x) ? c : mine; }
        if (sum == G) break;
        __builtin_amdgcn_s_sleep(1);
        if ((++sp & 255u) == 0u) { if (xb_ld(&bar[XB_TMO])) break; if (sp > XB_SPIN_CAP) { atomicAdd(&bar[XB_TMO], 1u); break; } }
    }
    nloc = mine > 0u ? mine : 1u; nx = cnt > 0u ? cnt : 1u;
}
__device__ __forceinline__ void xcd_barrier(const XcdBarrier& b) {
    asm volatile("s_waitcnt vmcnt(0)" ::: "memory");
    __syncthreads();
    if (threadIdx.x == 0) {
        unsigned* bar = b.bar;
        __builtin_amdgcn_s_waitcnt(0);
        unsigned nloc = b.st[0], nx = b.st[1];
        if (nloc == 0u) { xcd_barrier_complete(bar, b.x, nloc, nx); b.st[0] = nloc; b.st[1] = nx; }
        const unsigned old = xb_add(&bar[XB_XSUB(b.x)], 1u);
        const unsigned gen = old / nloc;
        if (old + 1u == (gen + 1u) * nloc) {
            __builtin_amdgcn_fence(__ATOMIC_RELEASE, "agent");
            asm volatile("s_waitcnt vmcnt(0)" ::: "memory");
            const unsigned og = xb_add(&bar[XB_TOP], 1u);
            const unsigned tg = og / nx;
            if (og + 1u == (tg + 1u) * nx) xb_add(&bar[XB_TOPGEN], 1u);
            else XB_SPIN(xb_ld(&bar[XB_TOPGEN]) == tg, bar);
            __builtin_amdgcn_fence(__ATOMIC_ACQUIRE, "agent");
            xb_add(&bar[XB_XGEN(b.x)], 1u);
            asm volatile("s_waitcnt vmcnt(0)" ::: "memory");
        } else {
            XB_SPIN(xb_ld(&bar[XB_XGEN(b.x)]) == gen, bar);
            __builtin_amdgcn_fence(__ATOMIC_ACQUIRE, "agent");
            asm volatile("s_waitcnt vmcnt(0)" ::: "memory");
        }
    }
    __syncthreads();
}

struct Frame {
    LAS unsigned char* lds;
    int tid, lane, wave, vcu, G;
    const float *x, *g_mix, *w_in, *conv_w, *conv_b, *w_rg_r, *b_rg_r, *w_rg_i, *b_rg_i, *lam, *w_br_rnn, *w_br_attn, *w_out, *g_mlp, *w_up, *w_dn, *g_fin;
    float* out; unsigned char* ws; unsigned* ctl;
    bf16 *WinTb, *WrT, *WiT, *PA, *QKV, *IQ, *IK, *IW, *GATES, *XN, *H1, *H2;
    unsigned char *WinT8, *XN8, *WbrT, *WoT, *WupT, *WdnT, *YAB, *MIXED, *A2, *ACT;
    unsigned* MASK; float *TMP, *ssq1, *ssq2;
};

__device__ __forceinline__ float wave_sum(float v) {
#pragma unroll
    for (int o = 1; o < 64; o <<= 1) v += __shfl_xor(v, o);
    return v;
}

__device__ __forceinline__ int win_src_col(int n) {
    if (n < 6144) return n;
    if (n < 10240) return n + 80;
    const int w = n - 10240; return w < 80 ? 6144 + w : -1;
}
template <bool F8>
__device__ __forceinline__ void transpose_item(const float* __restrict__ W, int Nsrc, int Ndst, int mapmode, void* WTv, int ldk, int kdst0, const float* kscale, float wscale, LAS float* scr, int item, int lane) {
    const int nblk = Ndst / 32, kb = item / nblk, nb = item % nblk, k0 = 64 * kb, n0 = 32 * nb;
    const int n = n0 + (lane & 31);
    const int sc = (mapmode == 0) ? n : (mapmode == 1) ? win_src_col(n < 5120 ? n : n + 1024) : win_src_col(n < 1024 ? 5120 + n : 9216 + n);
    float tv[32];
#pragma unroll
    for (int i = 0; i < 32; ++i) { const int kk = 2 * i + (lane >> 5); tv[i] = sc >= 0 ? W[(size_t)(k0 + kk) * Nsrc + sc] : 0.f; }
    if (kscale) {
#pragma unroll
        for (int i = 0; i < 32; ++i) tv[i] *= kscale[k0 + 2 * i + (lane >> 5)]; }
#pragma unroll
    for (int i = 0; i < 32; ++i) scr[(2 * i + (lane >> 5)) * 33 + (lane & 31)] = tv[i] * wscale;
    asm volatile("s_waitcnt lgkmcnt(0)" ::: "memory");
    const int c = lane & 7;
#pragma unroll
    for (int j = 0; j < 4; ++j) { const int nn = (lane >> 3) + 8 * j; const LAS float* s = scr + (8 * c) * 33 + nn;
        if (F8) { u32x2 o; o.x = pk4_fp8(s[0 * 33], s[1 * 33], s[2 * 33], s[3 * 33]); o.y = pk4_fp8(s[4 * 33], s[5 * 33], s[6 * 33], s[7 * 33]);
            *(u32x2*)((unsigned char*)WTv + (size_t)(n0 + nn) * ldk + kdst0 + k0 + 8 * c) = o; }
        else { u32x4 o; o.x = cvt_pk_bf16(s[0 * 33], s[1 * 33]); o.y = cvt_pk_bf16(s[2 * 33], s[3 * 33]); o.z = cvt_pk_bf16(s[4 * 33], s[5 * 33]); o.w = cvt_pk_bf16(s[6 * 33], s[7 * 33]);
            *(u32x4*)((bf16*)WTv + (size_t)(n0 + nn) * ldk + kdst0 + k0 + 8 * c) = o; } }
    asm volatile("s_waitcnt lgkmcnt(0)" ::: "memory");
}
constexpr int I_IN8 = 32 * (9216 / 32), I_INB = 32 * (1280 / 32), I_BR = 16 * 64, I_O = 32 * 64, I_UP = 32 * 256, I_DN = 128 * 64, I_RG = 16 * 2;
constexpr int N_LATE = 2 * I_BR + I_O + I_UP + I_DN;
__device__ __forceinline__ void late_transposes(Frame& F, unsigned* qword) {
    LAS float* scr = (LAS float*)(F.lds + F.wave * 16384);
    for (;;) {
        unsigned it = 0u;
        if (F.lane == 0) it = __hip_atomic_fetch_add(qword, 1u, __ATOMIC_RELAXED, __HIP_MEMORY_SCOPE_AGENT);
        int r = (int)__builtin_amdgcn_readfirstlane(it);
        if (r >= N_LATE) break;
        if (r < I_BR) { transpose_item<true>(F.w_br_rnn, 2048, 2048, 0, F.WbrT, 2048, 0, nullptr, WBR_SCALE, scr, r, F.lane); continue; } r -= I_BR;
        if (r < I_BR) { transpose_item<true>(F.w_br_attn, 2048, 2048, 0, F.WbrT, 2048, 1024, nullptr, WBR_SCALE, scr, r, F.lane); continue; } r -= I_BR;
        if (r < I_O)  { transpose_item<true>(F.w_out, 2048, 2048, 0, F.WoT, 2048, 0, nullptr, WO_SCALE, scr, r, F.lane); continue; } r -= I_O;
        if (r < I_UP) { transpose_item<true>(F.w_up, 8192, 8192, 0, F.WupT, 2048, 0, F.g_mlp, WUP_SCALE, scr, r, F.lane); continue; } r -= I_UP;
        transpose_item<true>(F.w_dn, 2048, 2048, 0, F.WdnT, 8192, 0, nullptr, WDN_SCALE, scr, r, F.lane);
    }
}
__device__ __forceinline__ void p0_prologue(Frame& F) {
    LAS float* scr = (LAS float*)(F.lds + F.wave * 16384);
    const int gw = F.vcu * NWAVES + F.wave, NGW = F.G * NWAVES;
    constexpr int NITEMS = I_IN8 + I_INB + 2 * I_RG + (LATE_TRANSPOSE ? 0 : N_LATE);
    for (int it = gw; it < NITEMS; it += NGW) {
        int r = it;
        if (!LATE_TRANSPOSE) {
            if (r < I_BR) { transpose_item<true>(F.w_br_rnn, 2048, 2048, 0, F.WbrT, 2048, 0, nullptr, WBR_SCALE, scr, r, F.lane); continue; } r -= I_BR;
            if (r < I_BR) { transpose_item<true>(F.w_br_attn, 2048, 2048, 0, F.WbrT, 2048, 1024, nullptr, WBR_SCALE, scr, r, F.lane); continue; } r -= I_BR;
            if (r < I_O)  { transpose_item<true>(F.w_out, 2048, 2048, 0, F.WoT, 2048, 0, nullptr, WO_SCALE, scr, r, F.lane); continue; } r -= I_O;
            if (r < I_UP) { transpose_item<true>(F.w_up, 8192, 8192, 0, F.WupT, 2048, 0, F.g_mlp, WUP_SCALE, scr, r, F.lane); continue; } r -= I_UP;
            if (r < I_DN) { transpose_item<true>(F.w_dn, 2048, 2048, 0, F.WdnT, 8192, 0, nullptr, WDN_SCALE, scr, r, F.lane); continue; } r -= I_DN;
        }
        if (r < I_IN8) { transpose_item<true>(F.w_in, 10320, 9216, 1, F.WinT8, 2048, 0, nullptr, WIN_SCALE, scr, r, F.lane); continue; } r -= I_IN8;
        if (r < I_INB) { transpose_item<false>(F.w_in, 10320, 1280, 2, F.WinTb, 2048, 0, nullptr, 1.f, scr, r, F.lane); continue; } r -= I_INB;
        if (r < I_RG) { transpose_item<false>(F.w_rg_r + (size_t)(r >> 1) * 4096, 64, 64, 0, F.WrT + (size_t)(r >> 1) * 4096, 64, 0, nullptr, 1.f, scr, r & 1, F.lane); continue; } r -= I_RG;
        transpose_item<false>(F.w_rg_i + (size_t)(r >> 1) * 4096, 64, 64, 0, F.WiT + (size_t)(r >> 1) * 4096, 64, 0, nullptr, 1.f, scr, r & 1, F.lane);
    }
    f32x4 gv[8];
#pragma unroll
    for (int j = 0; j < 8; ++j) gv[j] = *((const f32x4*)F.g_mix + F.lane + 64 * j);
    for (int m = gw; m < M; m += NGW) {
        const f32x4* xr = (const f32x4*)(F.x + (size_t)m * D) + F.lane;
        f32x4 v[8]; float s = 0.f;
#pragma unroll
        for (int j = 0; j < 8; ++j) { v[j] = xr[64 * j]; s += (v[j].x * v[j].x + v[j].y * v[j].y) + (v[j].z * v[j].z + v[j].w * v[j].w); }
        const float rstd = __builtin_amdgcn_rsqf(wave_sum(s) * (1.0f / D) + NORM_EPS);
        u32x2* o8 = (u32x2*)(F.XN + (size_t)m * D) + F.lane; unsigned* o4 = (unsigned*)(F.XN8 + (size_t)m * D) + F.lane;
#pragma unroll
        for (int j = 0; j < 8; ++j) { const f32x4 y = v[j] * rstd * gv[j]; u32x2 w; w.x = cvt_pk_bf16(y.x, y.y); w.y = cvt_pk_bf16(y.z, y.w); o8[64 * j] = w; o4[64 * j] = pk4_fp8(y.x, y.y, y.z, y.w); }
    }
}

__device__ __forceinline__ void rnn_unit(Frame& F, int b, int n, int half) {
    LAS float* XCS = (LAS float*)F.lds + F.wave * (32 * 33);
    LAS float* CW = (LAS float*)(F.lds + 8 * 4224);
    LAS f32x2* SEG = (LAS f32x2*)(F.lds + 8 * 4224 + 1280);
    LAS unsigned char* RX = F.lds + 40960 + F.wave * 5120;
    const int tid = F.tid, lane = F.lane, wave = F.wave, r32 = lane & 31, hi = lane >> 5;
    const int c0 = 64 * n, ce = c0 + 32 * half;
    __syncthreads();
    if (tid < 320) CW[tid] = (tid < 256) ? F.conv_w[(tid >> 6) * 1024 + c0 + (tid & 63)] : F.conv_b[c0 + (tid & 63)];
    const float br = F.b_rg_r[ce + r32], bi = F.b_rg_i[ce + r32];
    const float lamv = F.lam[ce + r32];
    const float sp = (-lamv > 20.f) ? -lamv : log1pf(__expf(-lamv));
    const float Kc2 = 8.0f * sp * LOG2E;
    bf16x8 Br[4], Bi[4];
#pragma unroll
    for (int ks = 0; ks < 4; ++ks) { const size_t o = (size_t)n * 4096 + (size_t)(32 * half + r32) * 64 + 8 * hi + 16 * ks;
        Br[ks] = *(const bf16x8*)(F.WrT + o); Bi[ks] = *(const bf16x8*)(F.WiT + o); }
    float hc = 0.f;
    __syncthreads();
    for (int chunk = 0; chunk < 8; ++chunk) {
        const int t = chunk * 256 + wave * 32 + r32;
        const size_t grow = (size_t)b * SEQ + t;
        const size_t orow0 = (size_t)b * SEQ + chunk * 256 + wave * 32;
        bf16 gq[16];
#pragma unroll
        for (int r = 0; r < 16; ++r) gq[r] = F.PA[(orow0 + crow(r, hi)) * 2048 + 1024 + ce + r32];
        {
            const int tw0 = chunk * 256 + wave * 32 - 3; const int q = lane & 7;
#pragma unroll
            for (int k = 0; k < 5; ++k) { const int i = 8 * k + (lane >> 3); const int tk = tw0 + i;
                u32x4 xw = {0u, 0u, 0u, 0u};
                if (tk >= 0 && i < 35) xw = *(const u32x4*)(F.PA + ((size_t)b * SEQ + tk) * 2048 + c0 + 8 * q);
                *(LAS u32x4*)(RX + i * 128 + ((q ^ ((i >> 1) & 7)) << 4)) = xw; }
            asm volatile("s_waitcnt lgkmcnt(0)" ::: "memory");
        }
        bf16x8 Af[4];
#pragma unroll
        for (int ks = 0; ks < 4; ++ks) {
            const int d0 = 8 * hi + 16 * ks;
            float xc[8];
            { const f32x4 cb0 = *(const LAS f32x4*)(CW + 256 + d0), cb1 = *(const LAS f32x4*)(CW + 256 + d0 + 4);
              xc[0] = cb0.x; xc[1] = cb0.y; xc[2] = cb0.z; xc[3] = cb0.w; xc[4] = cb1.x; xc[5] = cb1.y; xc[6] = cb1.z; xc[7] = cb1.w; }
#pragma unroll
            for (int j = 0; j < 4; ++j) {
                const int i = r32 + j;
                const u32x4 xw = *(const LAS u32x4*)(RX + i * 128 + (((hi + 2 * ks) ^ ((i >> 1) & 7)) << 4));
                const f32x4 w0 = *(const LAS f32x4*)(CW + j * 64 + d0), w1 = *(const LAS f32x4*)(CW + j * 64 + d0 + 4);
                xc[0] += w0.x * bflo(xw.x); xc[1] += w0.y * bfhi(xw.x); xc[2] += w0.z * bflo(xw.y); xc[3] += w0.w * bfhi(xw.y);
                xc[4] += w1.x * bflo(xw.z); xc[5] += w1.y * bfhi(xw.z); xc[6] += w1.z * bflo(xw.w); xc[7] += w1.w * bfhi(xw.w);
            }
            u32x4 aw; aw.x = cvt_pk_bf16(xc[0], xc[1]); aw.y = cvt_pk_bf16(xc[2], xc[3]); aw.z = cvt_pk_bf16(xc[4], xc[5]); aw.w = cvt_pk_bf16(xc[6], xc[7]);
            Af[ks] = __builtin_bit_cast(bf16x8, aw);
            if ((ks >> 1) == half) {
#pragma unroll
                for (int i = 0; i < 8; ++i) XCS[r32 * 33 + (ks & 1) * 16 + 8 * hi + i] = xc[i];
            }
        }
        f32x16 Cr = {}, Ci = {};
#pragma unroll
        for (int ks = 0; ks < 4; ++ks) { Cr = __builtin_amdgcn_mfma_f32_32x32x16_bf16(Af[ks], Br[ks], Cr, 0, 0, 0); Ci = __builtin_amdgcn_mfma_f32_32x32x16_bf16(Af[ks], Bi[ks], Ci, 0, 0, 0); }
        asm volatile("s_waitcnt lgkmcnt(0)" ::: "memory");
        float hl[16], P[16];
#pragma unroll
        for (int r = 0; r < 16; ++r) {
            const float xcv = XCS[crow(r, hi) * 33 + r32];
            const float rr = fast_sigmoid(Cr[r] + br), ii = fast_sigmoid(Ci[r] + bi);
            const float l2a = -Kc2 * rr;
            const float a = __builtin_amdgcn_exp2f(l2a);
            const float tt = 2.0f * 0.6931471805599453f * l2a;
            const float om = (tt > -0.25f) ? -tt * (1.0f + tt * (0.5f + tt * (0.16666667f + tt * (0.041666668f + tt * 0.008333334f)))) : 1.0f - a * a;
            P[r] = a; hl[r] = __builtin_amdgcn_sqrtf(fmaxf(om, 0.f)) * ii * xcv;
        }
#pragma unroll
        for (int g = 0; g < 4; ++g)
#pragma unroll
            for (int i = 1; i < 4; ++i) { hl[4 * g + i] = P[4 * g + i] * hl[4 * g + i - 1] + hl[4 * g + i]; P[4 * g + i] = P[4 * g + i] * P[4 * g + i - 1]; }
        float cown[4], qown[4]; float c = 0.f, q = 1.f;
#pragma unroll
        for (int g = 0; g < 4; ++g) {
            const float Ag = P[4 * g + 3], Hg = hl[4 * g + 3];
            const float oA = __shfl_xor(Ag, 32), oH = __shfl_xor(Hg, 32);
            const float A1 = hi ? oA : Ag, H1 = hi ? oH : Hg, A2 = hi ? Ag : oA, H2 = hi ? Hg : oH;
            const float c1 = A1 * c + H1, q1 = A1 * q;
            cown[g] = hi ? c1 : c; qown[g] = hi ? q1 : q;
            c = A2 * c1 + H2; q = A2 * q1;
        }
        if (hi == 0) SEG[(chunk & 1) * 256 + wave * 32 + r32] = (f32x2){q, c};
        __syncthreads();
        float cin = hc, my = 0.f;
#pragma unroll
        for (int w = 0; w < 8; ++w) { const f32x2 sg = SEG[(chunk & 1) * 256 + w * 32 + r32]; my = (w == wave) ? cin : my; cin = sg.x * cin + sg.y; }
        hc = cin;
#pragma unroll
        for (int r = 0; r < 16; ++r) {
            const int g = r >> 2; const float cg = cown[g] + qown[g] * my;
            const float y = (hl[r] + P[r] * cg) * bf2f(gq[r]);
            F.YAB[(orow0 + crow(r, hi)) * 2048 + ce + r32] = f2fp8(y);
        }
    }
}

__device__ __forceinline__ unsigned ord_key(float v) { const unsigned u = __float_as_uint(v); return u ^ ((unsigned)((int)u >> 31) | 0x80000000u); }
__device__ __forceinline__ void idx_unit(Frame& F, int b, int qi) {
    const int tid = F.tid, lane = F.lane, wave = F.wave, c = lane & 31, hi = lane >> 5;
    const int t0 = 16 * qi + 2 * wave, myt = t0 + hi;
    const size_t brow = (size_t)b * SEQ;
    bf16x8 Af[4];
    { const int q = (c >> 2) & 1, hh = (c & 3) + 4 * (c >> 3);
#pragma unroll
      for (int ks = 0; ks < 4; ++ks) Af[ks] = *(const bf16x8*)(F.IQ + (brow + t0 + q) * 1024 + hh * 64 + 8 * hi + 16 * ks); }
    float wv[16];
    { const u32x4 w0 = *(const u32x4*)(F.IW + (brow + myt) * 16), w1 = *(const u32x4*)(F.IW + (brow + myt) * 16 + 8);
      const float sc = 0.25f * 0.125f;
      wv[0] = bflo(w0.x) * sc; wv[1] = bfhi(w0.x) * sc; wv[2] = bflo(w0.y) * sc; wv[3] = bfhi(w0.y) * sc; wv[4] = bflo(w0.z) * sc; wv[5] = bfhi(w0.z) * sc; wv[6] = bflo(w0.w) * sc; wv[7] = bfhi(w0.w) * sc;
      wv[8] = bflo(w1.x) * sc; wv[9] = bfhi(w1.x) * sc; wv[10] = bflo(w1.y) * sc; wv[11] = bfhi(w1.y) * sc; wv[12] = bflo(w1.z) * sc; wv[13] = bfhi(w1.z) * sc; wv[14] = bflo(w1.w) * sc; wv[15] = bfhi(w1.w) * sc; }
    const int ntile = ((t0 + 1) >> 5) + 1;
    const int ntile_wg = ((16 * qi + 15) >> 5) + 1;
    int boff[4];
#pragma unroll
    for (int ks = 0; ks < 4; ++ks) boff[ks] = c * 128 + (((2 * ks + hi) ^ ((c >> 1) & 7)) << 4);
    unsigned keys[64];
#pragma unroll
    for (int j = 0; j < 64; ++j) keys[j] = 0u;
    unsigned isrc[8];
#pragma unroll
    for (int i = 0; i < 8; ++i) { const int row = (wave * 8 + i) * 8 + (lane >> 3), cpos = lane & 7; isrc[i] = (unsigned)(row * 128 + ((cpos ^ ((row >> 1) & 7)) << 4)); }
#define IDX_DMA(BUF, blk_) do { const char* kt_ = (const char*)(F.IK + (brow + (blk_) * 512) * 64); _Pragma("unroll") for (int i = 0; i < 8; ++i) { \
        unsigned io_ = isrc[i]; asm volatile("" : "+v"(io_)); \
        __builtin_amdgcn_global_load_lds((const unsigned*)(kt_ + io_), (LAS unsigned*)(F.lds + (BUF) * 65536 + (wave * 8 + i) * 1024), 16, 0, 0); } } while (0)
    IDX_DMA(0, 0);
#pragma unroll
    for (int blk = 0; blk < 4; ++blk) if (blk * 16 < ntile_wg) {
        asm volatile("s_waitcnt vmcnt(0)" ::: "memory"); __syncthreads();
        if ((blk + 1) * 16 < ntile_wg) { if (blk & 1) IDX_DMA(0, blk + 1); else IDX_DMA(1, blk + 1); }
#pragma unroll
        for (int jj = 0; jj < 16; ++jj) { const int j = blk * 16 + jj;
            if (j < ntile) {
                bf16x8 Bf[4];
#pragma unroll
                for (int ks = 0; ks < 4; ++ks) Bf[ks] = *(const LAS bf16x8*)(F.lds + (blk & 1) * 65536 + jj * 4096 + boff[ks]);
                f32x16 acc = {};
#pragma unroll
                for (int ks = 0; ks < 4; ++ks) acc = __builtin_amdgcn_mfma_f32_32x32x16_bf16(Af[ks], Bf[ks], acc, 0, 0, 0);
                float v = 0.f;
#pragma unroll
                for (int r = 0; r < 16; ++r) v += wv[r] * fmaxf(acc[r], 0.f);
                keys[j] = (32 * j + c <= myt) ? ord_key(v) : 0u;
            } }
    }
#undef IDX_DMA
    unsigned T = 1u;
    if (t0 >= 256) {
        T = 0u; bool done = false;
        for (int bit = 31; bit >= 0; --bit) {
            const unsigned cand = T | (1u << bit);
            int cnt = 0;
#pragma unroll
            for (int jb = 0; jb < 4; ++jb) if (jb * 16 < ntile) {
#pragma unroll
                for (int j = jb * 16; j < jb * 16 + 16; ++j) cnt += (keys[j] >= cand) ? 1 : 0; }
            cnt += __shfl_xor(cnt, 1); cnt += __shfl_xor(cnt, 2); cnt += __shfl_xor(cnt, 4); cnt += __shfl_xor(cnt, 8); cnt += __shfl_xor(cnt, 16);
            if (!done) { if (cnt >= 256) T = cand; if (cnt == 256) done = true; }
            if (__all(done)) break;
        }
    }
    int res0 = 0, res1 = 0;
#pragma unroll
    for (int jb = 0; jb < 4; ++jb) if (jb * 16 < ntile) {
#pragma unroll
        for (int j = jb * 16; j < jb * 16 + 16; ++j) {
            const unsigned long long bm = __ballot(keys[j] >= T);
            res0 = (lane == j) ? (int)(unsigned)bm : res0;
            res1 = (lane == j) ? (int)(unsigned)(bm >> 32) : res1;
        } }
    F.MASK[(brow + t0) * 64 + lane] = (unsigned)res0;
    F.MASK[(brow + t0 + 1) * 64 + lane] = (unsigned)res1;
}

#define KSWZ(row, colB) ((row) * 256 + ((colB) ^ (((row) & 7) << 4)))
__device__ __forceinline__ int v_st(int k, int c) { const int kk = (k & ~0xC) | ((k & 4) << 1) | ((k & 8) >> 1); return ((kk >> 3) * 4 + (c >> 5)) * 512 + ((kk & 7) * 32 + (c & 31)) * 2; }
__device__ __forceinline__ int v_rd_base(int lane) { return ((lane & 3) << 3) | (((lane >> 2) & 3) << 6) | (((lane >> 4) & 1) << 5) | (((lane >> 5) & 1) << 8); }
constexpr int v_rd_off(int d0, int ks, int half) { return d0 * 512 + ks * 4096 + half * 2048; }
constexpr int AT_V = 0, AT_K = 32768, AT_Q = 65536, AT_SCR = RING_BYTES + 1024;
static_assert(AT_Q + 8 * 8192 <= RING_BYTES && AT_SCR >= MISC_OFF + 128 && AT_SCR + 2048 <= LDS_BYTES, "attention LDS map");

__device__ __forceinline__ void attn_block(Frame& F, int b, int h, int qb) {
    const int tid = F.tid, lane = F.lane, wid = F.wave, r32 = lane & 31, hi = lane >> 5;
    LAS unsigned char* V_lds = F.lds + AT_V; LAS unsigned char* K_lds = F.lds + AT_K;
    LAS float* li_l = (LAS float*)(F.lds + AT_SCR) + wid * 64; LAS float* al_l = li_l + 32;
    const size_t brow = (size_t)b * SEQ;
    const bf16* Qp = F.QKV + (brow + qb * 256) * 3072 + h * 128;
    const bf16* Kp = F.QKV + brow * 3072 + 1024 + h * 128;
    const bf16* Vp = F.QKV + brow * 3072 + 2048 + h * 128;
    const int qpos = qb * 256 + wid * 32 + r32;
    const int qlast = qb * 256 + wid * 32 + 31;
    LAS unsigned char* Q_lds = F.lds + AT_Q + wid * 8192 + r32 * 256;
#pragma unroll
    for (int d0 = 0; d0 < 8; ++d0) *(LAS bf16x8*)(Q_lds + (((2 * d0 + hi) ^ (r32 & 15)) << 4)) = *(const bf16x8*)(Qp + (size_t)(wid * 32 + r32) * 3072 + d0 * 16 + hi * 8);
    const float slope2 = __builtin_amdgcn_exp2f(-(float)(h + 1)) * LOG2E;
    const unsigned* mrow = F.MASK + (brow + qpos) * 64;
    float m_reg = -1e30f, l_reg = 0.f; f32x16 o[4] = {};
    const int vb0 = (int)(unsigned)(uintptr_t)V_lds + v_rd_base(lane);
    const int nt = 4 * (qb + 1);
    unsigned ksrc[2], vsrc[2];
#pragma unroll
    for (int i = 0; i < 2; ++i) { const int sl = (wid * 2 + i) * 64 + lane;
        { const int row = sl >> 4, cpos = sl & 15; ksrc[i] = (unsigned)(row * 6144 + ((cpos ^ (row & 7)) << 4)); }
        { const int sub = sl >> 5, w = sl & 31, kk = (sub >> 2) * 8 + (w >> 2), k = (kk & ~0xC) | ((kk & 4) << 1) | ((kk & 8) >> 1), cc = (sub & 3) * 32 + (w & 3) * 8; vsrc[i] = (unsigned)(k * 6144 + cc * 2); } }
#define AT_DMA(BUF, kb_) do { const char* kt_ = (const char*)Kp + (size_t)(kb_) * 6144; const char* vt_ = (const char*)Vp + (size_t)(kb_) * 6144; _Pragma("unroll") for (int i = 0; i < 2; ++i) { \
        unsigned ko_ = ksrc[i], vo_ = vsrc[i]; asm volatile("" : "+v"(ko_), "+v"(vo_)); \
        __builtin_amdgcn_global_load_lds((const unsigned*)(kt_ + ko_), (LAS unsigned*)(K_lds + (BUF) * 16384 + (wid * 2 + i) * 1024), 16, 0, 0); \
        __builtin_amdgcn_global_load_lds((const unsigned*)(vt_ + vo_), (LAS unsigned*)(V_lds + (BUF) * 16384 + (wid * 2 + i) * 1024), 16, 0, 0); } } while (0)
#define AT_SYNC() do { asm volatile("s_waitcnt vmcnt(0)" ::: "memory"); __syncthreads(); } while (0)
#define PK4(P, B_, OUT) do { unsigned a0 = cvt_pk_bf16(P[B_+0], P[B_+1]), a1 = cvt_pk_bf16(P[B_+2], P[B_+3]);                          \
        unsigned b0 = cvt_pk_bf16(P[B_+4], P[B_+5]), b1 = cvt_pk_bf16(P[B_+6], P[B_+7]);                                             \
        auto r0 = __builtin_amdgcn_permlane32_swap(a0, b0, false, false); auto r1 = __builtin_amdgcn_permlane32_swap(a1, b1, false, false); \
        u32x4 w = {r0[0], r1[0], r0[1], r1[1]}; OUT = __builtin_bit_cast(bf16x8, w); } while (0)
#define TRRD(dst, off) asm volatile("ds_read_b64_tr_b16 %0, %1 offset:%2" : "=&v"(dst) : "v"(vb0), "i"(off) : "memory")
#define PV_D0(BUF, d0) do { s16x4 l0, l1, l2, l3, h0, h1, h2, h3; constexpr int b_ = (BUF) * 16384 + v_rd_off(d0, 0, 0); \
        TRRD(l0, b_); TRRD(h0, b_ + 2048); TRRD(l1, b_ + 4096); TRRD(h1, b_ + 6144); TRRD(l2, b_ + 8192); TRRD(h2, b_ + 10240); TRRD(l3, b_ + 12288); TRRD(h3, b_ + 14336); \
        asm volatile("s_waitcnt lgkmcnt(0)" ::: "memory"); __builtin_amdgcn_sched_barrier(0);   \
        o[d0] = __builtin_amdgcn_mfma_f32_32x32x16_bf16(pa0, (bf16x8){l0[0], l0[1], l0[2], l0[3], h0[0], h0[1], h0[2], h0[3]}, o[d0], 0, 0, 0);   \
        o[d0] = __builtin_amdgcn_mfma_f32_32x32x16_bf16(pa1, (bf16x8){l1[0], l1[1], l1[2], l1[3], h1[0], h1[1], h1[2], h1[3]}, o[d0], 0, 0, 0);   \
        o[d0] = __builtin_amdgcn_mfma_f32_32x32x16_bf16(pa2, (bf16x8){l2[0], l2[1], l2[2], l2[3], h2[0], h2[1], h2[2], h2[3]}, o[d0], 0, 0, 0);   \
        o[d0] = __builtin_amdgcn_mfma_f32_32x32x16_bf16(pa3, (bf16x8){l3[0], l3[1], l3[2], l3[3], h3[0], h3[1], h3[2], h3[3]}, o[d0], 0, 0, 0); } while (0)
#define AT_COMPUTE(BUF, t_) do { const int kb = (t_) * 64; if (kb <= qlast) {                                                     \
            f32x16 p0, p1;                                                                                                         \
            const float base = slope2 * (float)(kb + 4 * hi - qpos);                                                               \
            _Pragma("unroll") for (int r = 0; r < 16; ++r) { const float cr = (float)((r & 3) + 8 * (r >> 2)); p0[r] = base + slope2 * cr; p1[r] = base + slope2 * (cr + 32.f); } \
            _Pragma("unroll") for (int d0 = 0; d0 < 8; ++d0) {                                                                     \
                const int cB = ((d0 & 3) * 16 + hi * 8) * 2;                                                                       \
                const LAS unsigned char* a = K_lds + (BUF) * 16384 + KSWZ(r32, cB) + (d0 >> 2) * 128;                              \
                const bf16x8 b0 = *(const LAS bf16x8*)a, b1 = *(const LAS bf16x8*)(a + 32 * 256);                                  \
                const bf16x8 qd = *(const LAS bf16x8*)(Q_lds + (((2 * d0 + hi) ^ (r32 & 15)) << 4));                               \
                p0 = __builtin_amdgcn_mfma_f32_32x32x16_bf16(b0, qd, p0, 0, 0, 0);                                                 \
                p1 = __builtin_amdgcn_mfma_f32_32x32x16_bf16(b1, qd, p1, 0, 0, 0); }                                               \
            const unsigned w0 = mw.x >> (4 * hi), w1 = mw.y >> (4 * hi);                                                           \
            const float NEG = -__builtin_inff();                                                                                   \
            _Pragma("unroll") for (int r = 0; r < 16; ++r) { const int cr = (r & 3) + 8 * (r >> 2);                                \
                if (!((w0 >> cr) & 1u)) p0[r] = NEG;                                                                               \
                if (!((w1 >> cr) & 1u)) p1[r] = NEG; }                                                                             \
            float pmax = p0[0];                                                                                                    \
            _Pragma("unroll") for (int r = 1; r < 16; ++r) pmax = fmaxf(pmax, p0[r]);                                              \
            _Pragma("unroll") for (int r = 0; r < 16; ++r) pmax = fmaxf(pmax, p1[r]);                                              \
            { auto rr = __builtin_amdgcn_permlane32_swap(__float_as_uint(pmax), __float_as_uint(pmax), false, false);              \
              pmax = fmaxf(__uint_as_float(rr[0]), __uint_as_float(rr[1])); }                                                      \
            const float mn = fmaxf(m_reg, pmax);                                                                                   \
            const float alpha = __builtin_amdgcn_exp2f(m_reg - mn);                                                                \
            m_reg = mn;                                                                                                            \
            float ps = 0.f;                                                                                                        \
            _Pragma("unroll") for (int r = 0; r < 16; ++r) { p0[r] = __builtin_amdgcn_exp2f(p0[r] - mn); p1[r] = __builtin_amdgcn_exp2f(p1[r] - mn); ps += p0[r] + p1[r]; } \
            { auto rr = __builtin_amdgcn_permlane32_swap(__float_as_uint(ps), __float_as_uint(ps), false, false);                  \
              ps = __uint_as_float(rr[0]) + __uint_as_float(rr[1]); }                                                              \
            l_reg = l_reg * alpha + ps;                                                                                            \
            if (__any(alpha < 1.f)) {                            \
                if (hi == 0) al_l[r32] = alpha;                                                                                    \
                asm volatile("s_waitcnt lgkmcnt(0)" ::: "memory");                                                                 \
                _Pragma("unroll") for (int r = 0; r < 16; ++r) { const float al = al_l[crow(r, hi)];                               \
                    _Pragma("unroll") for (int d = 0; d < 4; ++d) o[d][r] *= al; } }                                               \
            bf16x8 pa0, pa1, pa2, pa3;                                                                                             \
            PK4(p0, 0, pa0); PK4(p0, 8, pa1); PK4(p1, 0, pa2); PK4(p1, 8, pa3);                                                    \
            PV_D0(BUF, 0); PV_D0(BUF, 1); PV_D0(BUF, 2); PV_D0(BUF, 3);                                                            \
        } } while (0)
    __syncthreads();
    AT_DMA(0, 0);
    u32x2 mw;
    for (int t = 0; t < nt; t += 2) {
        AT_SYNC(); mw = *(const u32x2*)(mrow + 2 * t); AT_DMA(1, (t + 1) * 64); AT_COMPUTE(0, t);
        AT_SYNC(); mw = *(const u32x2*)(mrow + 2 * t + 2); if (t + 2 < nt) AT_DMA(0, (t + 2) * 64); AT_COMPUTE(1, t + 1);
    }
#undef AT_DMA
#undef AT_SYNC
#undef AT_COMPUTE
#undef PV_D0
#undef TRRD
#undef PK4
    if (hi == 0) li_l[r32] = l_reg;
    asm volatile("s_waitcnt lgkmcnt(0)" ::: "memory");
    unsigned char* Ow = F.YAB + (brow + qb * 256 + wid * 32) * 2048 + 1024 + h * 128;
#pragma unroll
    for (int r = 0; r < 16; ++r) { const int orow = crow(r, hi); const float rl = __builtin_amdgcn_rcpf(li_l[orow]);
#pragma unroll
        for (int d0 = 0; d0 < 4; ++d0) { const float v = o[d0][r] * rl; const float v1 = __shfl_xor(v, 1); const float v2 = __shfl_xor(v, 2), v3 = __shfl_xor(v1, 2);
            if ((r32 & 3) == 0) *(unsigned*)(Ow + (size_t)orow * 2048 + d0 * 32 + r32) = pk4_fp8(v, v1, v2, v3); } }
}

struct Args { const float* in[17]; float* out; unsigned char* ws; int ph_lo, ph_hi, li, pad; };
__global__ void __launch_bounds__(NWAVES * 64, 2) fwd(Args args) {
    extern __shared__ __attribute__((aligned(16))) unsigned char lds_raw[];
    Frame F;
    F.lds = (LAS unsigned char*)lds_raw;
    volatile LAS unsigned* MISC = (volatile LAS unsigned*)(F.lds + MISC_OFF);
    F.tid = threadIdx.x; F.lane = F.tid & 63; F.wave = __builtin_amdgcn_readfirstlane(F.tid >> 6);
    F.G = gridDim.x; { const int bx = blockIdx.x; F.vcu = (F.G % 8 == 0) ? (bx % 8) * (F.G / 8) + bx / 8 : bx; }
    unsigned char* ws = args.ws; F.ws = ws; F.ctl = (unsigned*)(ws + WS_CTL);
    F.x = args.in[0]; F.g_mix = args.in[1]; F.w_in = args.in[2]; F.conv_w = args.in[3]; F.conv_b = args.in[4]; F.w_rg_r = args.in[5]; F.b_rg_r = args.in[6];
    F.w_rg_i = args.in[7]; F.b_rg_i = args.in[8]; F.lam = args.in[9]; F.w_br_rnn = args.in[10]; F.w_br_attn = args.in[11]; F.w_out = args.in[12]; F.g_mlp = args.in[13];
    F.w_up = args.in[14]; F.w_dn = args.in[15]; F.g_fin = args.in[16]; F.out = args.out;
    F.WinT8 = ws + WS_WIN; F.WinTb = (bf16*)(ws + WS_WIN + 18 * MiB); F.WbrT = ws + WS_WBR; F.WoT = ws + WS_WO; F.WupT = ws + WS_WUP; F.WdnT = ws + WS_WDN;
    F.WrT = (bf16*)(ws + WS_WRT); F.WiT = (bf16*)(ws + WS_WRT + 131072);
    F.PA = (bf16*)(ws + WS_PA); F.QKV = (bf16*)(ws + WS_QKV); F.IQ = (bf16*)(ws + WS_IQ); F.IK = (bf16*)(ws + WS_IKW); F.IW = (bf16*)(ws + WS_IKW + 2 * MiB); F.GATES = (bf16*)(ws + WS_GATES);
    F.MIXED = ws + WS_MIXED; F.H1 = (bf16*)(ws + WS_H1); F.H2 = (bf16*)(ws + WS_H2); F.A2 = ws + WS_A2; F.ACT = ws + WS_ACT;
    F.XN = (bf16*)args.out; F.XN8 = (unsigned char*)args.out + 64 * MiB; F.YAB = (unsigned char*)args.out;
    F.MASK = (unsigned*)(ws + WS_MASK); F.TMP = (float*)(ws + WS_TMP); F.ssq1 = (float*)(F.ctl + CW_SSQ1); F.ssq2 = (float*)(F.ctl + CW_SSQ2);
    for (int u = F.tid; u < (LDS_BYTES - RING_BYTES) / 4; u += NWAVES * 64) ((LAS unsigned*)(F.lds + RING_BYTES))[u] = 0u;
    __syncthreads();
    XcdBarrier bar; bar.bar = F.ctl + CW_BAR; bar.x = 0; bar.st = nullptr;
    if (MK_N_LAUNCHES == 1) bar = xcd_barrier_post(F.ctl + CW_BAR + args.li * XCD_BAR_WORDS, MISC + 8);
#define GRID_BAR() do { if (MK_N_LAUNCHES == 1) xcd_barrier(bar); } while (0)
    const int lo = args.ph_lo, hi = args.ph_hi;
#ifndef PHASE_MASK
#define PHASE_MASK 0x1ff
#endif
#define IN(k) (((PHASE_MASK >> (k)) & 1) && lo <= (k) && (k) < hi)
#define BOTH(k) (IN(k) && IN((k) + 1))

    if (IN(0)) { p0_prologue(F); if (BOTH(0)) GRID_BAR(); }

    if (IN(1)) {
        { pg8::Gemm g{F.XN8, F.WinT8, 2048, 2048, 2048};
          EpiProj<0> E{F.PA, F.QKV, F.IQ, F.IK, F.IW, F.GATES};
          if (F.G == 256) { pg8::InprojOrder S; S.S.init(M, 9216, F.G, (int)blockIdx.x); pg8::gemm_phase<EpiProj<0>, pg8::InprojOrder, true>(F.lds, g, S, E); }
          else { pg8::StaticOrder S; S.init(M, 9216, F.G, (int)blockIdx.x); pg8::gemm_phase<EpiProj<0>, pg8::StaticOrder, true>(F.lds, g, S, E); } }
        __syncthreads();
        { pg8::Gemm g{F.XN, F.WinTb, 4096, 4096, 4096}; pg8::StaticOrder S; S.init(M, 1280, F.G, (int)blockIdx.x);
          EpiProj<1> E{F.PA, F.QKV, F.IQ, F.IK, F.IW, F.GATES};
          pg8::gemm_phase<EpiProj<1>, pg8::StaticOrder, false>(F.lds, g, S, E); }
        __syncthreads();
        if (LATE_TRANSPOSE) late_transposes(F, F.ctl + CW_LATEQ + 64 * args.li);
        if (BOTH(1)) GRID_BAR();
    }

    if (IN(2)) {
        for (int u = blockIdx.x; u < 128; u += F.G) { rnn_unit(F, u >> 4, u & 15, 0); rnn_unit(F, u >> 4, u & 15, 1); }
        volatile LAS unsigned* qslot = MISC + 16;
        for (;;) {
            __syncthreads();
            if (F.tid == 0) *qslot = __hip_atomic_fetch_add(F.ctl + CW_IDXQ + 64 * args.li, 1u, __ATOMIC_RELAXED, __HIP_MEMORY_SCOPE_AGENT);
            __syncthreads();
            const unsigned p = *qslot;
            if (p >= 1024u) break;
            const int uu = 1023 - (int)p;
            idx_unit(F, uu & 7, uu >> 3);
        }
        if (BOTH(2)) GRID_BAR();
    }

    if (IN(3)) {
        for (int p = blockIdx.x; p < 256; p += F.G) { const int bh = p >> 2, pr = p & 3;
            attn_block(F, bh >> 3, bh & 7, 7 - pr); attn_block(F, bh >> 3, bh & 7, pr); }
        if (BOTH(3)) GRID_BAR();
    }

    if (IN(4)) {
        pg8::Gemm g{F.YAB, F.WbrT, 1024, 2048, 2048}; pg8::PairOrder S; S.S.init(M, 2048, F.G, (int)blockIdx.x);
        EpiBranch E{F.GATES, F.MIXED, F.TMP + (size_t)blockIdx.x * 65536};
        pg8::gemm_phase<EpiBranch, pg8::PairOrder, true>(F.lds, g, S, E);
        if (BOTH(4)) GRID_BAR();
    }

    if (IN(5)) {
        pg8::Gemm g{F.MIXED, F.WoT, 2048, 2048, 2048}; pg8::StaticOrder S; S.init(M, 2048, F.G, (int)blockIdx.x);
        EpiResid<true, false> E{F.x, F.H1, F.A2, F.ssq1, 1.0f / WO_SCALE};
        pg8::gemm_phase<EpiResid<true, false>, pg8::StaticOrder, true>(F.lds, g, S, E);
        if (BOTH(5)) GRID_BAR();
    }

    if (IN(6)) {
        pg8::Gemm g{F.A2, F.WupT, 2048, 2048, 2048}; pg8::StaticOrder S; S.init(M, DFF, F.G, (int)blockIdx.x);
        EpiUp E{F.ssq1, F.ACT};
        pg8::gemm_phase<EpiUp, pg8::StaticOrder, true>(F.lds, g, S, E);
        if (BOTH(6)) GRID_BAR();
    }

    if (IN(7)) {
        pg8::Gemm g{F.ACT, F.WdnT, 8192, 8192, 8192}; pg8::StaticOrder S; S.init(M, 2048, F.G, (int)blockIdx.x);
        EpiResid<false, true> E{F.H1, F.H2, nullptr, F.ssq2, 1.0f / WDN_SCALE};
        pg8::gemm_phase<EpiResid<false, true>, pg8::StaticOrder, true>(F.lds, g, S, E);
        if (BOTH(7)) GRID_BAR();
    }

    if (IN(8)) {
        const int gw = F.vcu * NWAVES + F.wave, NGW = F.G * NWAVES;
        f32x4 gv[8];
#pragma unroll
        for (int j = 0; j < 8; ++j) gv[j] = *((const f32x4*)F.g_fin + F.lane + 64 * j);
        for (int m = gw; m < M; m += NGW) {
            const float rstd = __builtin_amdgcn_rsqf(__hip_atomic_load(F.ssq2 + m, __ATOMIC_RELAXED, __HIP_MEMORY_SCOPE_AGENT) * (1.0f / D) + NORM_EPS);
            const u32x2* hr = (const u32x2*)(F.H2 + (size_t)m * D) + F.lane;
            f32x4* xr = (f32x4*)(F.out + (size_t)m * D) + F.lane;
            u32x2 hw[8];
#pragma unroll
            for (int j = 0; j < 8; ++j) hw[j] = hr[64 * j];
#pragma unroll
            for (int j = 0; j < 8; ++j) xr[64 * j] = (f32x4){bflo(hw[j].x), bfhi(hw[j].x), bflo(hw[j].y), bfhi(hw[j].y)} * rstd * gv[j];
        }
    }
#undef IN
#undef BOTH
#undef GRID_BAR
}

extern "C" void kernel_launch(void* const* d_in, const int* in_sizes, int n_in, void* d_out, int out_size, void* d_ws, size_t ws_size, hipStream_t stream) {
    static int grid = 0;
    if (grid == 0) {
        if (n_in != 17 || out_size != M * D || ws_size < WS_END) { fprintf(stderr, "kernel_launch: unexpected shapes (n_in %d, out %d, ws %zu)\n", n_in, out_size, ws_size); grid = -1; return; }
        int dev = 0, cus = 0, per_cu = 0;
        if (hipGetDevice(&dev) != hipSuccess || hipDeviceGetAttribute(&cus, hipDeviceAttributeMultiprocessorCount, dev) != hipSuccess) { grid = -1; return; }
        if (hipFuncSetAttribute((const void*)fwd, hipFuncAttributeMaxDynamicSharedMemorySize, LDS_BYTES) != hipSuccess) { fprintf(stderr, "kernel_launch: hipFuncSetAttribute failed\n"); grid = -1; return; }
        if (hipOccupancyMaxActiveBlocksPerMultiprocessor(&per_cu, (const void*)fwd, NWAVES * 64, LDS_BYTES) != hipSuccess || per_cu < 1)
            fprintf(stderr, "kernel_launch: occupancy query reports %d workgroups per CU\n", per_cu);
        (void)hipGetLastError();
        grid = cus;
    }
    if (grid < 0) return;
    if (hipMemsetAsync((char*)d_ws + WS_CTL, 0, CTL_ZERO_BYTES, stream) != hipSuccess) return;
    Args a{};
    for (int i = 0; i < 17; ++i) a.in[i] = (const float*)d_in[i];
    a.out = (float*)d_out; a.ws = (unsigned char*)d_ws; a.pad = 0;
    if (MK_N_LAUNCHES == 1 && PROBE_DUP >= 0) {
        a.ph_lo = 0; a.ph_hi = PROBE_DUP + 1; a.li = 0; hipLaunchKernelGGL(fwd, dim3(grid), dim3(NWAVES * 64), LDS_BYTES, stream, a);
        a.ph_lo = PROBE_DUP; a.ph_hi = PROBE_DUP + 1; a.li = 1; hipLaunchKernelGGL(fwd, dim3(grid), dim3(NWAVES * 64), LDS_BYTES, stream, a);
        if (PROBE_DUP + 1 < NPHASE) { a.ph_lo = PROBE_DUP + 1; a.ph_hi = NPHASE; a.li = 2; hipLaunchKernelGGL(fwd, dim3(grid), dim3(NWAVES * 64), LDS_BYTES, stream, a); }
    } else if (MK_N_LAUNCHES == 1) {
        a.ph_lo = 0; a.ph_hi = NPHASE; a.li = 0;
        hipLaunchKernelGGL(fwd, dim3(grid), dim3(NWAVES * 64), LDS_BYTES, stream, a);
    } else {
        for (int li = 0; li < NPHASE; ++li) { a.ph_lo = li; a.ph_hi = li + 1; a.li = li;
            hipLaunchKernelGGL(fwd, dim3(grid), dim3(NWAVES * 64), LDS_BYTES, stream, a); }
    }
}
```

```cpp
#include <hip/hip_runtime.h>
#include <cstdio>
#include <cstdint>

#ifndef MK_N_LAUNCHES
#define MK_N_LAUNCHES 1
#endif
#ifndef LATE_TRANSPOSE
#define LATE_TRANSPOSE 0
#endif
#ifndef PROBE_DUP
#define PROBE_DUP (-1)
#endif

#define GAS __attribute__((address_space(1)))
#define LAS __attribute__((address_space(3)))
typedef unsigned short bf16;
typedef short bf16x8 __attribute__((ext_vector_type(8)));
typedef short s16x4 __attribute__((ext_vector_type(4)));
typedef float f32x4 __attribute__((ext_vector_type(4)));
typedef float f32x2 __attribute__((ext_vector_type(2)));
typedef float f32x16 __attribute__((ext_vector_type(16)));
typedef unsigned u32x4 __attribute__((ext_vector_type(4)));
typedef unsigned u32x2 __attribute__((ext_vector_type(2)));
typedef GAS unsigned gu32;
typedef int i32x4 __attribute__((ext_vector_type(4)));
typedef int i32x8 __attribute__((ext_vector_type(8)));

constexpr int NWAVES = 8;
constexpr int BATCH = 8, SEQ = 2048, M = BATCH * SEQ, D = 2048, DFF = 8192;
constexpr int NPROJ = 10496;
constexpr float NORM_EPS = 1e-6f;
constexpr float LOG2E = 1.4426950408889634f;
constexpr float QSCALE = 0.08838834764831845f * LOG2E;
constexpr int NPHASE = 9;

constexpr size_t MiB = 1u << 20;
constexpr size_t WS_CTL = 0, CTL_ZERO_BYTES = 1 * MiB;
constexpr size_t WS_WIN = 2 * MiB;
constexpr size_t WS_WBR = 43 * MiB;
constexpr size_t WS_WO = 51 * MiB;
constexpr size_t WS_WUP = 59 * MiB;
constexpr size_t WS_WDN = 91 * MiB;
constexpr size_t WS_WRT = 123 * MiB;
constexpr size_t WS_MASK = 124 * MiB;
constexpr size_t WS_PA = 128 * MiB;
constexpr size_t WS_QKV = 192 * MiB;
constexpr size_t WS_IQ = 288 * MiB;
constexpr size_t WS_IKW = 320 * MiB;
constexpr size_t WS_GATES = 328 * MiB;
constexpr size_t WS_END = 456 * MiB;
constexpr size_t WS_H1 = 328 * MiB;
constexpr size_t WS_H2 = 392 * MiB;
constexpr size_t WS_MIXED = WS_QKV;
constexpr size_t WS_TMP = 256 * MiB;
constexpr size_t WS_A2 = WS_PA;
constexpr size_t WS_ACT = WS_QKV;
constexpr int CW_BAR = 4096;
constexpr int CW_LATEQ = 16384 + 1024;
constexpr int CW_IDXQ = 16384;
constexpr int CW_SSQ1 = 32768;
constexpr int CW_SSQ2 = 32768 + 16384;
static_assert((CW_SSQ2 + 16384) * 4 <= (int)CTL_ZERO_BYTES, "ctl");

constexpr int LDS_BYTES = 147456;
constexpr int RING_BYTES = 131072;
constexpr int MISC_OFF = RING_BYTES + 320;

__device__ __forceinline__ unsigned cvt_pk_bf16(float lo, float hi) { unsigned r; asm volatile("v_cvt_pk_bf16_f32 %0, %1, %2" : "=v"(r) : "v"(lo), "v"(hi)); return r; }
__device__ __forceinline__ unsigned pk4_fp8(float a, float b, float c, float d) { int w = 0; w = __builtin_amdgcn_cvt_pk_fp8_f32(a, b, w, false); w = __builtin_amdgcn_cvt_pk_fp8_f32(c, d, w, true); return (unsigned)w; }
constexpr float WUP_SCALE = 64.f, WDN_SCALE = 128.f, WIN_SCALE = 64.f, WBR_SCALE = 32.f, WO_SCALE = 64.f;
__device__ __forceinline__ unsigned char f2fp8(float a) { return (unsigned char)(__builtin_amdgcn_cvt_pk_fp8_f32(a, a, 0, false) & 0xff); }
__device__ __forceinline__ float bflo(unsigned w) { return __uint_as_float(w << 16); }
__device__ __forceinline__ float bfhi(unsigned w) { return __uint_as_float(w & 0xffff0000u); }
__device__ __forceinline__ float bf2f(bf16 b) { return __uint_as_float(((unsigned)b) << 16); }
__device__ __forceinline__ float fast_sigmoid(float x) { return __builtin_amdgcn_rcpf(1.0f + __builtin_amdgcn_exp2f(-LOG2E * x)); }
__device__ __forceinline__ float gelu_tanh(float x) { const float u = x + 0.044715f * x * x * x; return x * __builtin_amdgcn_rcpf(1.0f + __builtin_amdgcn_exp2f(-2.0f * 0.7978845608f * LOG2E * u)); }
__device__ __forceinline__ int crow(int r, int hi) { return (r & 3) + 8 * (r >> 2) + 4 * hi; }

namespace pg8 {
constexpr int BM = 256, BK = 64, HALF = 128, HTB = HALF * BK * 2, STAGE_BYTES = 8 * HTB, NXCD = 8, WGM = 8;
__host__ __device__ __forceinline__ int lds_byte(int r, int c) { const int st = (r >> 4) * 2 + (c >> 5), rr = r & 15, cc = c & 31, ob = rr * 64 + cc * 2; return st * 1024 + (ob ^ (((ob >> 9) & 1) << 5)); }
__host__ __device__ __forceinline__ void stage_rc(int b, int& R, int& C) { const int st = b / 1024, sb = b % 1024, swz = sb ^ (((sb >> 9) & 1) << 5); R = (st >> 1) * 16 + swz / 64; C = (st & 1) * 32 + (swz % 64) / 2; }
__host__ __device__ __forceinline__ int perm32(int rho) { const int n = rho >> 4, i = rho & 15; return 8 * (i >> 2) + 4 * n + (i & 3); }

struct Unit { int pm, pn, kh; };
struct Gemm { const void* A; const void* Bt; int Kb, lda, ldb; };

struct StaticOrder {
    int nM, nN, nwg, G, c;
    __device__ void init(int M_, int N_, int G_, int c_) { nM = M_ / BM; nN = N_ / BM; nwg = nM * nN; G = G_; c = c_; }
    __device__ bool next(int i, Unit& u) const {
        const long L = (long)i * G + c; if (L >= nwg) return false;
        int wgid = (int)L; { const int q = nwg / NXCD, r = nwg % NXCD, xcd = wgid % NXCD, off = wgid / NXCD; wgid = (xcd < r ? xcd * (q + 1) : r * (q + 1) + (xcd - r) * q) + off; }
        const int nig = WGM * nN, gid = wgid / nig, fm = gid * WGM, gsz = (nM - fm) < WGM ? (nM - fm) : WGM;
        u.pm = fm + ((wgid % nig) % gsz); u.pn = (wgid % nig) / gsz; u.kh = 0; return true;
    }
};
struct InprojOrder {
    StaticOrder S;
    __device__ bool next(int i, Unit& u) const {
        long L;
        if (i < 7) L = (long)i * 256 + S.c;
        else { if (S.c < 64) return false; const int e = (S.c - 64) + 192 * (i - 7); if (e >= 512) return false; L = 1792 + e; }
        int wgid = (int)L; { const int q = S.nwg / NXCD, r = S.nwg % NXCD, xcd = wgid % NXCD, off = wgid / NXCD; wgid = (xcd < r ? xcd * (q + 1) : r * (q + 1) + (xcd - r) * q) + off; }
        const int nig = WGM * S.nN, gid = wgid / nig, fm = gid * WGM, gsz = (S.nM - fm) < WGM ? (S.nM - fm) : WGM;
        u.pm = fm + ((wgid % nig) % gsz); u.pn = (wgid % nig) / gsz; u.kh = 0; return true;
    }
};
struct PairOrder {
    StaticOrder S;
    __device__ bool next(int i, Unit& u) const { if (!S.next(i >> 1, u)) return false; u.kh = i & 1; return true; }
};

template <class Epi, class Sched, bool FP8 = false>
__device__ __forceinline__ void gemm_phase(LAS unsigned char* lds, const Gemm g, const Sched& S, const Epi& E) {
    const int tid = threadIdx.x, wid = __builtin_amdgcn_readfirstlane(tid >> 6), lane = tid & 63, wr = wid >> 2, wc = wid & 3, fr = lane & 15, fq = lane >> 4;
    const int nt = g.Kb / (BK * 2);
    unsigned voffA[2], voffB[2];
#pragma unroll
    for (int i = 0; i < 2; ++i) { int R, C; stage_rc(tid * 16 + i * 8192, R, C); const int Rb = Epi::PERM ? ((R & ~31) + perm32(R & 31)) : R;
        voffA[i] = (unsigned)(R * g.lda + C * 2); voffB[i] = (unsigned)(Rb * g.ldb + C * 2); }
    const size_t kstep = (size_t)(BK * 2);
    const size_t hstepA = (size_t)HALF * g.lda, hstepB = (size_t)HALF * g.ldb;
    const size_t tstepA = 2 * hstepA, tstepB = 2 * hstepB, koff = (size_t)g.Kb;
    const unsigned ldsw = (unsigned)wid * 1024u;
    const int aoff = lds_byte(wr * 64 + fr, fq * 8), boff = lds_byte(wc * 32 + fr, fq * 8);
#define PG8_SA(b, h) (((b) * 2 + (h)) * HTB)
#define PG8_SB(b, h) ((4 + (b) * 2 + (h)) * HTB)
#define PG8_STAGE(bufoff, gbase, voff) do { _Pragma("unroll") for (int _i = 0; _i < 2; ++_i) \
        __builtin_amdgcn_global_load_lds((const unsigned*)((const char*)(gbase) + (voff)[_i]), (LAS unsigned*)(lds + (bufoff) + ldsw + _i * 8192), 16, 0, 0); } while (0)
#define PG8_LDA(dst, b, h) do { _Pragma("unroll") for (int m = 0; m < 4; ++m) { const i32x4 lo_ = *(const LAS i32x4*)(lds + PG8_SA(b, h) + aoff + m * 2048), hi_ = *(const LAS i32x4*)(lds + PG8_SA(b, h) + aoff + m * 2048 + 1024); \
        dst[m] = __builtin_shufflevector(lo_, hi_, 0, 1, 2, 3, 4, 5, 6, 7); } } while (0)
#define PG8_LDB(dst, b, h) do { _Pragma("unroll") for (int n = 0; n < 2; ++n) { const i32x4 lo_ = *(const LAS i32x4*)(lds + PG8_SB(b, h) + boff + n * 2048), hi_ = *(const LAS i32x4*)(lds + PG8_SB(b, h) + boff + n * 2048 + 1024); \
        dst[n] = __builtin_shufflevector(lo_, hi_, 0, 1, 2, 3, 4, 5, 6, 7); } } while (0)
#define PG8_MMA(ai, bj, At, Bt) do { __builtin_amdgcn_s_setprio(1); _Pragma("unroll") for (int m = 0; m < 4; ++m) _Pragma("unroll") for (int n = 0; n < 2; ++n) { \
        if constexpr (FP8) asm volatile("v_mfma_scale_f32_16x16x128_f8f6f4 %0, %1, %2, %0, %3, %3 op_sel_hi:[0,0,0]" : "+v"(acc[ai][bj][m][n]) : "v"(Bt[n]), "v"(At[m]), "v"(sc7f)); \
        else { acc[ai][bj][m][n] = __builtin_amdgcn_mfma_f32_16x16x32_bf16(__builtin_bit_cast(bf16x8, __builtin_shufflevector(Bt[n], Bt[n], 0, 1, 2, 3)), __builtin_bit_cast(bf16x8, __builtin_shufflevector(At[m], At[m], 0, 1, 2, 3)), acc[ai][bj][m][n], 0, 0, 0); \
               acc[ai][bj][m][n] = __builtin_amdgcn_mfma_f32_16x16x32_bf16(__builtin_bit_cast(bf16x8, __builtin_shufflevector(Bt[n], Bt[n], 4, 5, 6, 7)), __builtin_bit_cast(bf16x8, __builtin_shufflevector(At[m], At[m], 4, 5, 6, 7)), acc[ai][bj][m][n], 0, 0, 0); } } \
        __builtin_amdgcn_s_setprio(0); } while (0)
#define PG8_WAIT_V(n) asm volatile("s_waitcnt vmcnt(" #n ")" ::: "memory")
#define PG8_WAIT_L(n) asm volatile("s_waitcnt lgkmcnt(" #n ")" ::: "memory")
#define PG8_BAR __builtin_amdgcn_s_barrier()
#define PG8_SCHED __builtin_amdgcn_sched_barrier(0)
    Unit cur, nxt; int ui = 0;
    if (!S.next(0, cur)) return;
    f32x4 acc[2][2][4][2];
#pragma unroll
    for (int a = 0; a < 2; ++a)
#pragma unroll
        for (int b = 0; b < 2; ++b)
#pragma unroll
            for (int m = 0; m < 4; ++m)
#pragma unroll
                for (int n = 0; n < 2; ++n) acc[a][b][m][n] = (f32x4){0.f, 0.f, 0.f, 0.f};
    i32x8 At[4], B0[2], B1[2];
    const int sc7f = 0x7F7F7F7F;
    const char* cA = (const char*)g.A + (size_t)cur.pm * tstepA + (size_t)cur.kh * koff; const char* cB = (const char*)g.Bt + (size_t)cur.pn * tstepB + (size_t)cur.kh * koff;
    PG8_STAGE(PG8_SB(0, 0), cB, voffB); PG8_STAGE(PG8_SB(0, 1), cB + hstepB, voffB); PG8_STAGE(PG8_SA(0, 0), cA, voffA); PG8_STAGE(PG8_SA(0, 1), cA + hstepA, voffA);
    if (wr == 1) PG8_BAR;
    PG8_WAIT_V(2); PG8_BAR;
    PG8_STAGE(PG8_SB(1, 0), cB + kstep, voffB); PG8_STAGE(PG8_SA(1, 0), cA + kstep, voffA); PG8_STAGE(PG8_SB(1, 1), cB + hstepB + kstep, voffB);
    PG8_WAIT_V(6); PG8_BAR;
    for (;;) {
        const bool has_next = S.next(ui + 1, nxt);
        const char* nA = has_next ? (const char*)g.A + (size_t)nxt.pm * tstepA + (size_t)nxt.kh * koff : cA; const char* nB = has_next ? (const char*)g.Bt + (size_t)nxt.pn * tstepB + (size_t)nxt.kh * koff : cB;
        for (int t = 0; t < nt; t += 2) {
            const bool last = (t == nt - 2);
            const char* a1 = cA + (size_t)(t + 1) * kstep;
            const char* a2 = last ? nA : cA + (size_t)(t + 2) * kstep; const char* b2 = last ? nB : cB + (size_t)(t + 2) * kstep;
            const char* a3 = a2 + kstep; const char* b3 = b2 + kstep;
            PG8_LDB(B0, 0, 0); PG8_LDB(B1, 0, 1); PG8_SCHED; PG8_LDA(At, 0, 0); PG8_STAGE(PG8_SA(1, 1), a1 + hstepA, voffA);
            PG8_WAIT_V(8); PG8_WAIT_L(0); PG8_BAR; PG8_MMA(0, 0, At, B0); PG8_MMA(0, 1, At, B1); PG8_BAR; PG8_SCHED;
            PG8_LDA(At, 0, 1); PG8_STAGE(PG8_SB(0, 0), b2, voffB); PG8_STAGE(PG8_SB(0, 1), b2 + hstepB, voffB); PG8_STAGE(PG8_SA(0, 0), a2, voffA);
            PG8_WAIT_V(8); PG8_WAIT_L(0); PG8_BAR; PG8_MMA(1, 0, At, B0); PG8_MMA(1, 1, At, B1); PG8_BAR; PG8_SCHED;
            PG8_LDB(B0, 1, 0); PG8_LDB(B1, 1, 1); PG8_SCHED; PG8_LDA(At, 1, 0); PG8_STAGE(PG8_SA(0, 1), a2 + hstepA, voffA);
            PG8_WAIT_V(8); PG8_WAIT_L(0); PG8_BAR; PG8_MMA(0, 0, At, B0); PG8_MMA(0, 1, At, B1); PG8_BAR; PG8_SCHED;
            PG8_LDA(At, 1, 1); PG8_STAGE(PG8_SB(1, 0), b3, voffB); PG8_STAGE(PG8_SB(1, 1), b3 + hstepB, voffB); PG8_STAGE(PG8_SA(1, 0), a3, voffA);
            PG8_WAIT_V(8); PG8_WAIT_L(0); PG8_BAR; PG8_MMA(1, 0, At, B0); PG8_MMA(1, 1, At, B1); PG8_BAR; PG8_SCHED;
        }
        if (wr == 0) PG8_BAR;
        if constexpr (FP8) asm volatile("s_nop 15\n\ts_nop 15" ::: "memory");
        E(acc, cur, wr, wc, fr, fq);
        if (!has_next) break;
        if (!(Epi::KEEPS && cur.kh == 0)) {
#pragma unroll
        for (int a = 0; a < 2; ++a)
#pragma unroll
            for (int b = 0; b < 2; ++b)
#pragma unroll
                for (int m = 0; m < 4; ++m)
#pragma unroll
                    for (int n = 0; n < 2; ++n) acc[a][b][m][n] = (f32x4){0.f, 0.f, 0.f, 0.f};
        }
        cur = nxt; cA = nA; cB = nB; ++ui;
        if (wr == 1) PG8_BAR;
    }
    PG8_WAIT_V(0);
    PG8_BAR;
#undef PG8_SA
#undef PG8_SB
#undef PG8_STAGE
#undef PG8_LDA
#undef PG8_LDB
#undef PG8_MMA
#undef PG8_WAIT_V
#undef PG8_WAIT_L
#undef PG8_BAR
#undef PG8_SCHED
}
}

template <int MODE> struct EpiProj {
    static constexpr bool PERM = true, KEEPS = false;
    bf16 *PA, *QKV, *IQ, *IK, *IW, *GATES;
    __device__ __forceinline__ void operator()(const f32x4 (&acc)[2][2][4][2], const pg8::Unit& u, int wr, int wc, int fr, int fq) const {
        const int pn = (MODE == 0) ? (u.pn < 20 ? u.pn : u.pn + 4) : (u.pn < 4 ? 20 + u.pn : 40);
        const float asc = (MODE == 0) ? (1.0f / WIN_SCALE) : 1.0f;
        const int row0 = u.pm * 256 + wr * 64 + fr;
        if (MODE == 1 && pn == 40) {
            if (wc < 2 || (wc == 2 && fq < 2)) {
                bf16* dst = (wc < 2) ? IK + (size_t)row0 * 64 + wc * 32 + 8 * fq : IW + (size_t)row0 * 16 + 8 * fq; const int ld = (wc < 2) ? 64 : 16;
#pragma unroll
                for (int ai = 0; ai < 2; ++ai)
#pragma unroll
                    for (int m = 0; m < 4; ++m) { const f32x4 v0 = acc[ai][0][m][0], v1 = acc[ai][0][m][1];
                        u32x4 w; w.x = cvt_pk_bf16(v0[0], v0[1]); w.y = cvt_pk_bf16(v0[2], v0[3]); w.z = cvt_pk_bf16(v1[0], v1[1]); w.w = cvt_pk_bf16(v1[2], v1[3]);
                        *(u32x4*)(dst + (size_t)(ai * 128 + m * 16) * ld) = w; }
            }
            return;
        }
        bf16* base; int ldc, cofs, act;
        if (pn < 4)       { base = PA;    ldc = 2048; cofs = pn * 256;               act = 0; }
        else if (pn < 8)  { base = PA;    ldc = 2048; cofs = 1024 + (pn - 4) * 256;  act = 1; }
        else if (pn < 12) { base = QKV;   ldc = 3072; cofs = (pn - 8) * 256;         act = 3; }
        else if (pn < 20) { base = QKV;   ldc = 3072; cofs = 1024 + (pn - 12) * 256; act = 0; }
        else if (pn < 24) { base = IQ;    ldc = 1024; cofs = (pn - 20) * 256;        act = 0; }
        else              { base = GATES; ldc = 4096; cofs = (pn - 24) * 256;        act = 2; }
        const int col0 = cofs + wc * 32 + 8 * fq;
#pragma unroll
        for (int ai = 0; ai < 2; ++ai)
#pragma unroll
            for (int m = 0; m < 4; ++m) { bf16* rowp = base + (size_t)(row0 + ai * 128 + m * 16) * ldc + col0;
#pragma unroll
                for (int bj = 0; bj < 2; ++bj) { f32x4 v0 = acc[ai][bj][m][0] * asc, v1 = acc[ai][bj][m][1] * asc;
                    if (act == 1) {
#pragma unroll
                        for (int j = 0; j < 4; ++j) { v0[j] = gelu_tanh(v0[j]); v1[j] = gelu_tanh(v1[j]); } }
                    else if (act == 2) {
#pragma unroll
                        for (int j = 0; j < 4; ++j) { v0[j] = fast_sigmoid(v0[j]); v1[j] = fast_sigmoid(v1[j]); } }
                    else if (act == 3) { v0 = v0 * QSCALE; v1 = v1 * QSCALE; }
                    u32x4 w; w.x = cvt_pk_bf16(v0[0], v0[1]); w.y = cvt_pk_bf16(v0[2], v0[3]); w.z = cvt_pk_bf16(v1[0], v1[1]); w.w = cvt_pk_bf16(v1[2], v1[3]);
                    *(u32x4*)(rowp + bj * 128) = w; } }
    }
};
struct EpiBranch {
    static constexpr bool PERM = true, KEEPS = true;
    const bf16* GATES; unsigned char* MIXED;
    __device__ __forceinline__ void operator()(f32x4 (&acc)[2][2][4][2], const pg8::Unit& u, int wr, int wc, int fr, int fq) const {
        const int row0 = u.pm * 256 + wr * 64 + fr, col0 = u.pn * 256 + wc * 32 + 8 * fq;
        const bf16* gbase = GATES + col0;
#pragma unroll
        for (int ai = 0; ai < 2; ++ai)
#pragma unroll
        for (int mh = 0; mh < 2; ++mh) {
            u32x4 gb[2][2], ga[2][2];
#pragma unroll
            for (int mm = 0; mm < 2; ++mm)
#pragma unroll
                for (int bj = 0; bj < 2; ++bj) { const bf16* gp = gbase + (size_t)(row0 + ai * 128 + (2 * mh + mm) * 16) * 4096 + bj * 128;
                    gb[mm][bj] = *(const u32x4*)(gp + 2048); if (u.kh == 0) ga[mm][bj] = *(const u32x4*)gp; }
#pragma unroll
            for (int mm = 0; mm < 2; ++mm)
#pragma unroll
                for (int bj = 0; bj < 2; ++bj) { const int m = 2 * mh + mm; const u32x4 g = gb[mm][bj];
                    f32x4 b0 = {bflo(g.x), bfhi(g.x), bflo(g.y), bfhi(g.y)}, b1 = {bflo(g.z), bfhi(g.z), bflo(g.w), bfhi(g.w)};
                    if (u.kh == 0) { const u32x4 a = ga[mm][bj];
                        const f32x4 a0 = {bflo(a.x), bfhi(a.x), bflo(a.y), bfhi(a.y)}, a1 = {bflo(a.z), bfhi(a.z), bflo(a.w), bfhi(a.w)};
#pragma unroll
                        for (int j = 0; j < 4; ++j) { acc[ai][bj][m][0][j] *= a0[j] * __builtin_amdgcn_rcpf(fmaxf(b0[j], 1e-30f)); acc[ai][bj][m][1][j] *= a1[j] * __builtin_amdgcn_rcpf(fmaxf(b1[j], 1e-30f)); }
                    } else {
                        const f32x4 v0 = acc[ai][bj][m][0] * b0 * (1.0f / WBR_SCALE), v1 = acc[ai][bj][m][1] * b1 * (1.0f / WBR_SCALE);
                        u32x2 w; w.x = pk4_fp8(v0[0], v0[1], v0[2], v0[3]); w.y = pk4_fp8(v1[0], v1[1], v1[2], v1[3]);
                        *(u32x2*)(MIXED + (size_t)(row0 + ai * 128 + m * 16) * 2048 + col0 + bj * 128) = w; }
                }
            asm volatile("" ::: "memory");
        }
    }
};
template <bool WRITE_A2, bool HIN_BF16> struct EpiResid {
    static constexpr bool PERM = false, KEEPS = false;
    const void* hin; bf16* hout; unsigned char* A2; float* ssq; float accscale;
    __device__ __forceinline__ void operator()(const f32x4 (&acc)[2][2][4][2], const pg8::Unit& u, int wr, int wc, int fr, int fq) const {
        const int row0 = u.pm * 256 + wr * 64 + fr, col0 = u.pn * 256 + wc * 32 + 4 * fq;
#pragma unroll
        for (int ai = 0; ai < 2; ++ai)
#pragma unroll
            for (int m = 0; m < 4; ++m) { const int row = row0 + ai * 128 + m * 16; const size_t off = (size_t)row * 2048 + col0; float s = 0.f;
#pragma unroll
                for (int bj = 0; bj < 2; ++bj)
#pragma unroll
                    for (int n = 0; n < 2; ++n) { const size_t o = off + bj * 128 + n * 16; f32x4 hv;
                        if (HIN_BF16) { const u32x2 w = *(const u32x2*)((const bf16*)hin + o); hv = (f32x4){bflo(w.x), bfhi(w.x), bflo(w.y), bfhi(w.y)}; }
                        else hv = *(const f32x4*)((const float*)hin + o);
                        const f32x4 h = hv + acc[ai][bj][m][n] * accscale;
                        u32x2 ow; ow.x = cvt_pk_bf16(h[0], h[1]); ow.y = cvt_pk_bf16(h[2], h[3]); *(u32x2*)(hout + o) = ow;
                        s += (h[0] * h[0] + h[1] * h[1]) + (h[2] * h[2] + h[3] * h[3]);
                        if (WRITE_A2) *(unsigned*)(A2 + o) = pk4_fp8(h[0], h[1], h[2], h[3]); }
                s += __shfl_xor(s, 16); s += __shfl_xor(s, 32);
                if (fq == 0) atomicAdd(ssq + row, s); }
    }
};
struct EpiUp {
    static constexpr bool PERM = true, KEEPS = false;
    const float* ssq; unsigned char* ACT;
    __device__ __forceinline__ void operator()(const f32x4 (&acc)[2][2][4][2], const pg8::Unit& u, int wr, int wc, int fr, int fq) const {
        const int row0 = u.pm * 256 + wr * 64 + fr, col0 = u.pn * 256 + wc * 32 + 8 * fq;
        float rs[8];
#pragma unroll
        for (int i = 0; i < 8; ++i) rs[i] = __hip_atomic_load(ssq + row0 + (i >> 2) * 128 + (i & 3) * 16, __ATOMIC_RELAXED, __HIP_MEMORY_SCOPE_AGENT);
#pragma unroll
        for (int ai = 0; ai < 2; ++ai)
#pragma unroll
            for (int m = 0; m < 4; ++m) { const int row = row0 + ai * 128 + m * 16;
                const float rstd = __builtin_amdgcn_rsqf(rs[ai * 4 + m] * (1.0f / 2048.0f) + NORM_EPS) * (1.0f / WUP_SCALE);
                unsigned char* rowp = ACT + (size_t)row * 8192 + col0;
#pragma unroll
                for (int bj = 0; bj < 2; ++bj) { f32x4 v0 = acc[ai][bj][m][0] * rstd, v1 = acc[ai][bj][m][1] * rstd;
#pragma unroll
                    for (int j = 0; j < 4; ++j) { const float a = fmaxf(v0[j], 0.f), b = fmaxf(v1[j], 0.f); v0[j] = fminf(a * a, 448.f); v1[j] = fminf(b * b, 448.f); }
                    u32x2 w; w.x = pk4_fp8(v0[0], v0[1], v0[2], v0[3]); w.y = pk4_fp8(v1[0], v1[1], v1[2], v1[3]);
                    *(u32x2*)(rowp + bj * 128) = w; } }
    }
};

#define XB_TMO      128
#define XB_XCNT(j)  (256  + 64 * (j))
#define XB_XSUB(j)  (1280 + 64 * (j))
#define XB_XGEN(j)  (2304 + 64 * (j))
#define XB_TOP      3328
#define XB_TOPGEN   3392
#define XCD_BAR_WORDS 3456
#define XB_SPIN_CAP (1u << 18)
__device__ __forceinline__ unsigned xb_ld(unsigned* p)              { return __hip_atomic_load(p, __ATOMIC_RELAXED, __HIP_MEMORY_SCOPE_AGENT); }
__device__ __forceinline__ unsigned xb_add(unsigned* p, unsigned v) { return __hip_atomic_fetch_add(p, v, __ATOMIC_RELAXED, __HIP_MEMORY_SCOPE_AGENT); }
__device__ __forceinline__ unsigned xb_xcc_id() { return (unsigned)__builtin_amdgcn_s_getreg((3 << 11) | 20) & 0xFu; }
#define XB_SPIN(cond, bar) do { unsigned _sp = 0; while (cond) { __builtin_amdgcn_s_sleep(1); \
    if ((++_sp & 255u) == 0u) { if (xb_ld(&(bar)[XB_TMO])) break; if (_sp > XB_SPIN_CAP) { atomicAdd(&(bar)[XB_TMO], 1u); break; } } } } while (0)
struct XcdBarrier { unsigned* bar; unsigned x; volatile LAS unsigned* st; };
__device__ __forceinline__ XcdBarrier xcd_barrier_post(unsigned* bar, volatile LAS unsigned* st) {
    XcdBarrier b; b.bar = bar; b.x = xb_xcc_id(); b.st = st;
    if (threadIdx.x == 0) (void)xb_add(&bar[XB_XCNT(b.x)], 1u);
    return b;
}
__device__ __forceinline__ void xcd_barrier_complete(unsigned* bar, unsigned x, unsigned& nloc, unsigned& nx) {
    const unsigned G = gridDim.x * gridDim.y * gridDim.z;
    unsigned sum, cnt, mine, sp = 0u;
    for (;;) {
        sum = 0u; cnt = 0u; mine = 0u;
#pragma unroll
        for (unsigned j = 0; j < 16; ++j) { const unsigned c = xb_ld(&bar[XB_XCNT(j)]); sum += c; cnt += (c > 0u) ? 1u : 0u; mine = (j == x) ? c : mine; }
        if (sum == G) break;
        __builtin_amdgcn_s_sleep(1);
        if ((++sp & 255u) == 0u) { if (xb_ld(&bar[XB_TMO])) break; if (sp > XB_SPIN_CAP) { atomicAdd(&bar[XB_TMO], 1u); break; } }
    }
    nloc = mine > 0u ? mine : 1u; nx = cnt > 0u ? cnt : 1u;
}
__device__ __forceinline__ void xcd_barrier(const XcdBarrier& b) {
    asm volatile("s_waitcnt vmcnt(0)" ::: "memory");
    __syncthreads();
    if (threadIdx.x == 0) {
        unsigned* bar = b.bar;
        __builtin_amdgcn_s_waitcnt(0);
        unsigned nloc = b.st[0], nx = b.st[1];
        if (nloc == 0u) { xcd_barrier_complete(bar, b.x, nloc, nx); b.st[0] = nloc; b.st[1] = nx; }
        const unsigned old = xb_add(&bar[XB_XSUB(b.x)], 1u);
        const unsigned gen = old / nloc;
        if (old + 1u == (gen + 1u) * nloc) {
            __builtin_amdgcn_fence(__ATOMIC_RELEASE, "agent");
            asm volatile("s_waitcnt vmcnt(0)" ::: "memory");
            const unsigned og = xb_add(&bar[XB_TOP], 1u);
            const unsigned tg = og / nx;
            if (og + 1u == (tg + 1u) * nx) xb_add(&bar[XB_TOPGEN], 1u);
            else XB_SPIN(xb_ld(&bar[XB_TOPGEN]) == tg, bar);
            __builtin_amdgcn_fence(__ATOMIC_ACQUIRE, "agent");
            xb_add(&bar[XB_XGEN(b.x)], 1u);
            asm volatile("s_waitcnt vmcnt(0)" ::: "memory");
        } else {
            XB_SPIN(xb_ld(&bar[XB_XGEN(b.x)]) == gen, bar);
            __builtin_amdgcn_fence(__ATOMIC_ACQUIRE, "agent");
            asm volatile("s_waitcnt vmcnt(0)" ::: "memory");
        }
    }
    __syncthreads();
}

struct Frame {
    LAS unsigned char* lds;
    int tid, lane, wave, vcu, G;
    const float *x, *g_mix, *w_in, *conv_w, *conv_b, *w_rg_r, *b_rg_r, *w_rg_i, *b_rg_i, *lam, *w_br_rnn, *w_br_attn, *w_out, *g_mlp, *w_up, *w_dn, *g_fin;
    float* out; unsigned char* ws; unsigned* ctl;
    bf16 *WinTb, *WrT, *WiT, *PA, *QKV, *IQ, *IK, *IW, *GATES, *XN, *H1, *H2;
    unsigned char *WinT8, *XN8, *WbrT, *WoT, *WupT, *WdnT, *YAB, *MIXED, *A2, *ACT;
    unsigned* MASK; float *TMP, *ssq1, *ssq2;
};

__device__ __forceinline__ float wave_sum(float v) {
#pragma unroll
    for (int o = 1; o < 64; o <<= 1) v += __shfl_xor(v, o);
    return v;
}

__device__ __forceinline__ int win_src_col(int n) {
    if (n < 6144) return n;
    if (n < 10240) return n + 80;
    const int w = n - 10240; return w < 80 ? 6144 + w : -1;
}
template <bool F8>
__device__ __forceinline__ void transpose_item(const float* __restrict__ W, int Nsrc, int Ndst, int mapmode, void* WTv, int ldk, int kdst0, const float* kscale, float wscale, LAS float* scr, int item, int lane) {
    const int nblk = Ndst / 32, kb = item / nblk, nb = item % nblk, k0 = 64 * kb, n0 = 32 * nb;
    const int n = n0 + (lane & 31);
    const int sc = (mapmode == 0) ? n : (mapmode == 1) ? win_src_col(n < 5120 ? n : n + 1024) : win_src_col(n < 1024 ? 5120 + n : 9216 + n);
    float tv[32];
#pragma unroll
    for (int i = 0; i < 32; ++i) { const int kk = 2 * i + (lane >> 5); tv[i] = sc >= 0 ? W[(size_t)(k0 + kk) * Nsrc + sc] : 0.f; }
    if (kscale) {
#pragma unroll
        for (int i = 0; i < 32; ++i) tv[i] *= kscale[k0 + 2 * i + (lane >> 5)]; }
#pragma unroll
    for (int i = 0; i < 32; ++i) scr[(2 * i + (lane >> 5)) * 33 + (lane & 31)] = tv[i] * wscale;
    asm volatile("s_waitcnt lgkmcnt(0)" ::: "memory");
    const int c = lane & 7;
#pragma unroll
    for (int j = 0; j < 4; ++j) { const int nn = (lane >> 3) + 8 * j; const LAS float* s = scr + (8 * c) * 33 + nn;
        if (F8) { u32x2 o; o.x = pk4_fp8(s[0 * 33], s[1 * 33], s[2 * 33], s[3 * 33]); o.y = pk4_fp8(s[4 * 33], s[5 * 33], s[6 * 33], s[7 * 33]);
            *(u32x2*)((unsigned char*)WTv + (size_t)(n0 + nn) * ldk + kdst0 + k0 + 8 * c) = o; }
        else { u32x4 o; o.x = cvt_pk_bf16(s[0 * 33], s[1 * 33]); o.y = cvt_pk_bf16(s[2 * 33], s[3 * 33]); o.z = cvt_pk_bf16(s[4 * 33], s[5 * 33]); o.w = cvt_pk_bf16(s[6 * 33], s[7 * 33]);
            *(u32x4*)((bf16*)WTv + (size_t)(n0 + nn) * ldk + kdst0 + k0 + 8 * c) = o; } }
    asm volatile("s_waitcnt lgkmcnt(0)" ::: "memory");
}
constexpr int I_IN8 = 32 * (9216 / 32), I_INB = 32 * (1280 / 32), I_BR = 16 * 64, I_O = 32 * 64, I_UP = 32 * 256, I_DN = 128 * 64, I_RG = 16 * 2;
constexpr int N_LATE = 2 * I_BR + I_O + I_UP + I_DN;
__device__ __forceinline__ void late_transposes(Frame& F, unsigned* qword) {
    LAS float* scr = (LAS float*)(F.lds + F.wave * 16384);
    for (;;) {
        unsigned it = 0u;
        if (F.lane == 0) it = __hip_atomic_fetch_add(qword, 1u, __ATOMIC_RELAXED, __HIP_MEMORY_SCOPE_AGENT);
        int r = (int)__builtin_amdgcn_readfirstlane(it);
        if (r >= N_LATE) break;
        if (r < I_BR) { transpose_item<true>(F.w_br_rnn, 2048, 2048, 0, F.WbrT, 2048, 0, nullptr, WBR_SCALE, scr, r, F.lane); continue; } r -= I_BR;
        if (r < I_BR) { transpose_item<true>(F.w_br_attn, 2048, 2048, 0, F.WbrT, 2048, 1024, nullptr, WBR_SCALE, scr, r, F.lane); continue; } r -= I_BR;
        if (r < I_O)  { transpose_item<true>(F.w_out, 2048, 2048, 0, F.WoT, 2048, 0, nullptr, WO_SCALE, scr, r, F.lane); continue; } r -= I_O;
        if (r < I_UP) { transpose_item<true>(F.w_up, 8192, 8192, 0, F.WupT, 2048, 0, F.g_mlp, WUP_SCALE, scr, r, F.lane); continue; } r -= I_UP;
        transpose_item<true>(F.w_dn, 2048, 2048, 0, F.WdnT, 8192, 0, nullptr, WDN_SCALE, scr, r, F.lane);
    }
}
__device__ __forceinline__ void p0_prologue(Frame& F) {
    LAS float* scr = (LAS float*)(F.lds + F.wave * 16384);
    const int gw = F.vcu * NWAVES + F.wave, NGW = F.G * NWAVES;
    constexpr int NITEMS = I_IN8 + I_INB + 2 * I_RG + (LATE_TRANSPOSE ? 0 : N_LATE);
    for (int it = gw; it < NITEMS; it += NGW) {
        int r = it;
        if (!LATE_TRANSPOSE) {
            if (r < I_BR) { transpose_item<true>(F.w_br_rnn, 2048, 2048, 0, F.WbrT, 2048, 0, nullptr, WBR_SCALE, scr, r, F.lane); continue; } r -= I_BR;
            if (r < I_BR) { transpose_item<true>(F.w_br_attn, 2048, 2048, 0, F.WbrT, 2048, 1024, nullptr, WBR_SCALE, scr, r, F.lane); continue; } r -= I_BR;
            if (r < I_O)  { transpose_item<true>(F.w_out, 2048, 2048, 0, F.WoT, 2048, 0, nullptr, WO_SCALE, scr, r, F.lane); continue; } r -= I_O;
            if (r < I_UP) { transpose_item<true>(F.w_up, 8192, 8192, 0, F.WupT, 2048, 0, F.g_mlp, WUP_SCALE, scr, r, F.lane); continue; } r -= I_UP;
            if (r < I_DN) { transpose_item<true>(F.w_dn, 2048, 2048, 0, F.WdnT, 8192, 0, nullptr, WDN_SCALE, scr, r, F.lane); continue; } r -= I_DN;
        }
        if (r < I_IN8) { transpose_item<true>(F.w_in, 10320, 9216, 1, F.WinT8, 2048, 0, nullptr, WIN_SCALE, scr, r, F.lane); continue; } r -= I_IN8;
        if (r < I_INB) { transpose_item<false>(F.w_in, 10320, 1280, 2, F.WinTb, 2048, 0, nullptr, 1.f, scr, r, F.lane); continue; } r -= I_INB;
        if (r < I_RG) { transpose_item<false>(F.w_rg_r + (size_t)(r >> 1) * 4096, 64, 64, 0, F.WrT + (size_t)(r >> 1) * 4096, 64, 0, nullptr, 1.f, scr, r & 1, F.lane); continue; } r -= I_RG;
        transpose_item<false>(F.w_rg_i + (size_t)(r >> 1) * 4096, 64, 64, 0, F.WiT + (size_t)(r >> 1) * 4096, 64, 0, nullptr, 1.f, scr, r & 1, F.lane);
    }
    f32x4 gv[8];
#pragma unroll
    for (int j = 0; j < 8; ++j) gv[j] = *((const f32x4*)F.g_mix + F.lane + 64 * j);
    for (int m = gw; m < M; m += NGW) {
        const f32x4* xr = (const f32x4*)(F.x + (size_t)m * D) + F.lane;
        f32x4 v[8]; float s = 0.f;
#pragma unroll
        for (int j = 0; j < 8; ++j) { v[j] = xr[64 * j]; s += (v[j].x * v[j].x + v[j].y * v[j].y) + (v[j].z * v[j].z + v[j].w * v[j].w); }
        const float rstd = __builtin_amdgcn_rsqf(wave_sum(s) * (1.0f / D) + NORM_EPS);
        u32x2* o8 = (u32x2*)(F.XN + (size_t)m * D) + F.lane; unsigned* o4 = (unsigned*)(F.XN8 + (size_t)m * D) + F.lane;
#pragma unroll
        for (int j = 0; j < 8; ++j) { const f32x4 y = v[j] * rstd * gv[j]; u32x2 w; w.x = cvt_pk_bf16(y.x, y.y); w.y = cvt_pk_bf16(y.z, y.w); o8[64 * j] = w; o4[64 * j] = pk4_fp8(y.x, y.y, y.z, y.w); }
    }
}

__device__ __forceinline__ void rnn_unit(Frame& F, int b, int n, int half) {
    LAS float* XCS = (LAS float*)F.lds + F.wave * (32 * 33);
    LAS float* CW = (LAS float*)(F.lds + 8 * 4224);
    LAS f32x2* SEG = (LAS f32x2*)(F.lds + 8 * 4224 + 1280);
    LAS unsigned char* RX = F.lds + 40960 + F.wave * 5120;
    const int tid = F.tid, lane = F.lane, wave = F.wave, r32 = lane & 31, hi = lane >> 5;
    const int c0 = 64 * n, ce = c0 + 32 * half;
    __syncthreads();
    if (tid < 320) CW[tid] = (tid < 256) ? F.conv_w[(tid >> 6) * 1024 + c0 + (tid & 63)] : F.conv_b[c0 + (tid & 63)];
    const float br = F.b_rg_r[ce + r32], bi = F.b_rg_i[ce + r32];
    const float lamv = F.lam[ce + r32];
    const float sp = (-lamv > 20.f) ? -lamv : log1pf(__expf(-lamv));
    const float Kc2 = 8.0f * sp * LOG2E;
    bf16x8 Br[4], Bi[4];
#pragma unroll
    for (int ks = 0; ks < 4; ++ks) { const size_t o = (size_t)n * 4096 + (size_t)(32 * half + r32) * 64 + 8 * hi + 16 * ks;
        Br[ks] = *(const bf16x8*)(F.WrT + o); Bi[ks] = *(const bf16x8*)(F.WiT + o); }
    float hc = 0.f;
    __syncthreads();
    for (int chunk = 0; chunk < 8; ++chunk) {
        const int t = chunk * 256 + wave * 32 + r32;
        const size_t grow = (size_t)b * SEQ + t;
        const size_t orow0 = (size_t)b * SEQ + chunk * 256 + wave * 32;
        bf16 gq[16];
#pragma unroll
        for (int r = 0; r < 16; ++r) gq[r] = F.PA[(orow0 + crow(r, hi)) * 2048 + 1024 + ce + r32];
        {
            const int tw0 = chunk * 256 + wave * 32 - 3; const int q = lane & 7;
#pragma unroll
            for (int k = 0; k < 5; ++k) { const int i = 8 * k + (lane >> 3); const int tk = tw0 + i;
                u32x4 xw = {0u, 0u, 0u, 0u};
                if (tk >= 0 && i < 35) xw = *(const u32x4*)(F.PA + ((size_t)b * SEQ + tk) * 2048 + c0 + 8 * q);
                *(LAS u32x4*)(RX + i * 128 + ((q ^ ((i >> 1) & 7)) << 4)) = xw; }
            asm volatile("s_waitcnt lgkmcnt(0)" ::: "memory");
        }
        bf16x8 Af[4];
#pragma unroll
        for (int ks = 0; ks < 4; ++ks) {
            const int d0 = 8 * hi + 16 * ks;
            float xc[8];
            { const f32x4 cb0 = *(const LAS f32x4*)(CW + 256 + d0), cb1 = *(const LAS f32x4*)(CW + 256 + d0 + 4);
              xc[0] = cb0.x; xc[1] = cb0.y; xc[2] = cb0.z; xc[3] = cb0.w; xc[4] = cb1.x; xc[5] = cb1.y; xc[6] = cb1.z; xc[7] = cb1.w; }
#pragma unroll
            for (int j = 0; j < 4; ++j) {
                const int i = r32 + j;
                const u32x4 xw = *(const LAS u32x4*)(RX + i * 128 + (((hi + 2 * ks) ^ ((i >> 1) & 7)) << 4));
                const f32x4 w0 = *(const LAS f32x4*)(CW + j * 64 + d0), w1 = *(const LAS f32x4*)(CW + j * 64 + d0 + 4);
                xc[0] += w0.x * bflo(xw.x); xc[1] += w0.y * bfhi(xw.x); xc[2] += w0.z * bflo(xw.y); xc[3] += w0.w * bfhi(xw.y);
                xc[4] += w1.x * bflo(xw.z); xc[5] += w1.y * bfhi(xw.z); xc[6] += w1.z * bflo(xw.w); xc[7] += w1.w * bfhi(xw.w);
            }
            u32x4 aw; aw.x = cvt_pk_bf16(xc[0], xc[1]); aw.y = cvt_pk_bf16(xc[2], xc[3]); aw.z = cvt_pk_bf16(xc[4], xc[5]); aw.w = cvt_pk_bf16(xc[6], xc[7]);
            Af[ks] = __builtin_bit_cast(bf16x8, aw);
            if ((ks >> 1) == half) {
#pragma unroll
                for (int i = 0; i < 8; ++i) XCS[r32 * 33 + (ks & 1) * 16 + 8 * hi + i] = xc[i];
            }
        }
        f32x16 Cr = {}, Ci = {};
#pragma unroll
        for (int ks = 0; ks < 4; ++ks) { Cr = __builtin_amdgcn_mfma_f32_32x32x16_bf16(Af[ks], Br[ks], Cr, 0, 0, 0); Ci = __builtin_amdgcn_mfma_f32_32x32x16_bf16(Af[ks], Bi[ks], Ci, 0, 0, 0); }
        asm volatile("s_waitcnt lgkmcnt(0)" ::: "memory");
        float hl[16], P[16];
#pragma unroll
        for (int r = 0; r < 16; ++r) {
            const float xcv = XCS[crow(r, hi) * 33 + r32];
            const float rr = fast_sigmoid(Cr[r] + br), ii = fast_sigmoid(Ci[r] + bi);
            const float l2a = -Kc2 * rr;
            const float a = __builtin_amdgcn_exp2f(l2a);
            const float tt = 2.0f * 0.6931471805599453f * l2a;
            const float om = (tt > -0.25f) ? -tt * (1.0f + tt * (0.5f + tt * (0.16666667f + tt * (0.041666668f + tt * 0.008333334f)))) : 1.0f - a * a;
            P[r] = a; hl[r] = __builtin_amdgcn_sqrtf(fmaxf(om, 0.f)) * ii * xcv;
        }
#pragma unroll
        for (int g = 0; g < 4; ++g)
#pragma unroll
            for (int i = 1; i < 4; ++i) { hl[4 * g + i] = P[4 * g + i] * hl[4 * g + i - 1] + hl[4 * g + i]; P[4 * g + i] = P[4 * g + i] * P[4 * g + i - 1]; }
        float cown[4], qown[4]; float c = 0.f, q = 1.f;
#pragma unroll
        for (int g = 0; g < 4; ++g) {
            const float Ag = P[4 * g + 3], Hg = hl[4 * g + 3];
            const float oA = __shfl_xor(Ag, 32), oH = __shfl_xor(Hg, 32);
            const float A1 = hi ? oA : Ag, H1 = hi ? oH : Hg, A2 = hi ? Ag : oA, H2 = hi ? Hg : oH;
            const float c1 = A1 * c + H1, q1 = A1 * q;
            cown[g] = hi ? c1 : c; qown[g] = hi ? q1 : q;
            c = A2 * c1 + H2; q = A2 * q1;
        }
        if (hi == 0) SEG[(chunk & 1) * 256 + wave * 32 + r32] = (f32x2){q, c};
        __syncthreads();
        float cin = hc, my = 0.f;
#pragma unroll
        for (int w = 0; w < 8; ++w) { const f32x2 sg = SEG[(chunk & 1) * 256 + w * 32 + r32]; my = (w == wave) ? cin : my; cin = sg.x * cin + sg.y; }
        hc = cin;
#pragma unroll
        for (int r = 0; r < 16; ++r) {
            const int g = r >> 2; const float cg = cown[g] + qown[g] * my;
            const float y = (hl[r] + P[r] * cg) * bf2f(gq[r]);
            F.YAB[(orow0 + crow(r, hi)) * 2048 + ce + r32] = f2fp8(y);
        }
    }
}

__device__ __forceinline__ unsigned ord_key(float v) { const unsigned u = __float_as_uint(v); return u ^ ((unsigned)((int)u >> 31) | 0x80000000u); }
__device__ __forceinline__ void idx_unit(Frame& F, int b, int qi) {
    const int tid = F.tid, lane = F.lane, wave = F.wave, c = lane & 31, hi = lane >> 5;
    const int t0 = 16 * qi + 2 * wave, myt = t0 + hi;
    const size_t brow = (size_t)b * SEQ;
    bf16x8 Af[4];
    { const int q = (c >> 2) & 1, hh = (c & 3) + 4 * (c >> 3);
#pragma unroll
      for (int ks = 0; ks < 4; ++ks) Af[ks] = *(const bf16x8*)(F.IQ + (brow + t0 + q) * 1024 + hh * 64 + 8 * hi + 16 * ks); }
    float wv[16];
    { const u32x4 w0 = *(const u32x4*)(F.IW + (brow + myt) * 16), w1 = *(const u32x4*)(F.IW + (brow + myt) * 16 + 8);
      const float sc = 0.25f * 0.125f;
      wv[0] = bflo(w0.x) * sc; wv[1] = bfhi(w0.x) * sc; wv[2] = bflo(w0.y) * sc; wv[3] = bfhi(w0.y) * sc; wv[4] = bflo(w0.z) * sc; wv[5] = bfhi(w0.z) * sc; wv[6] = bflo(w0.w) * sc; wv[7] = bfhi(w0.w) * sc;
      wv[8] = bflo(w1.x) * sc; wv[9] = bfhi(w1.x) * sc; wv[10] = bflo(w1.y) * sc; wv[11] = bfhi(w1.y) * sc; wv[12] = bflo(w1.z) * sc; wv[13] = bfhi(w1.z) * sc; wv[14] = bflo(w1.w) * sc; wv[15] = bfhi(w1.w) * sc; }
    const int ntile = ((t0 + 1) >> 5) + 1;
    const int ntile_wg = ((16 * qi + 15) >> 5) + 1;
    int boff[4];
#pragma unroll
    for (int ks = 0; ks < 4; ++ks) boff[ks] = c * 128 + (((2 * ks + hi) ^ ((c >> 1) & 7)) << 4);
    unsigned keys[64];
#pragma unroll
    for (int j = 0; j < 64; ++j) keys[j] = 0u;
    unsigned isrc[8];
#pragma unroll
    for (int i = 0; i < 8; ++i) { const int row = (wave * 8 + i) * 8 + (lane >> 3), cpos = lane & 7; isrc[i] = (unsigned)(row * 128 + ((cpos ^ ((row >> 1) & 7)) << 4)); }
#define IDX_DMA(BUF, blk_) do { const char* kt_ = (const char*)(F.IK + (brow + (blk_) * 512) * 64); _Pragma("unroll") for (int i = 0; i < 8; ++i) { \
        unsigned io_ = isrc[i]; asm volatile("" : "+v"(io_)); \
        __builtin_amdgcn_global_load_lds((const unsigned*)(kt_ + io_), (LAS unsigned*)(F.lds + (BUF) * 65536 + (wave * 8 + i) * 1024), 16, 0, 0); } } while (0)
    IDX_DMA(0, 0);
#pragma unroll
    for (int blk = 0; blk < 4; ++blk) if (blk * 16 < ntile_wg) {
        asm volatile("s_waitcnt vmcnt(0)" ::: "memory"); __syncthreads();
        if ((blk + 1) * 16 < ntile_wg) { if (blk & 1) IDX_DMA(0, blk + 1); else IDX_DMA(1, blk + 1); }
#pragma unroll
        for (int jj = 0; jj < 16; ++jj) { const int j = blk * 16 + jj;
            if (j < ntile) {
                bf16x8 Bf[4];
#pragma unroll
                for (int ks = 0; ks < 4; ++ks) Bf[ks] = *(const LAS bf16x8*)(F.lds + (blk & 1) * 65536 + jj * 4096 + boff[ks]);
                f32x16 acc = {};
#pragma unroll
                for (int ks = 0; ks < 4; ++ks) acc = __builtin_amdgcn_mfma_f32_32x32x16_bf16(Af[ks], Bf[ks], acc, 0, 0, 0);
                float v = 0.f;
#pragma unroll
                for (int r = 0; r < 16; ++r) v += wv[r] * fmaxf(acc[r], 0.f);
                keys[j] = (32 * j + c <= myt) ? ord_key(v) : 0u;
            } }
    }
#undef IDX_DMA
    unsigned T = 1u;
    if (t0 >= 256) {
        T = 0u; bool done = false;
        for (int bit = 31; bit >= 0; --bit) {
            const unsigned cand = T | (1u << bit);
            int cnt = 0;
#pragma unroll
            for (int jb = 0; jb < 4; ++jb) if (jb * 16 < ntile) {
#pragma unroll
                for (int j = jb * 16; j < jb * 16 + 16; ++j) cnt += (keys[j] >= cand) ? 1 : 0; }
            cnt += __shfl_xor(cnt, 1); cnt += __shfl_xor(cnt, 2); cnt += __shfl_xor(cnt, 4); cnt += __shfl_xor(cnt, 8); cnt += __shfl_xor(cnt, 16);
            if (!done) { if (cnt >= 256) T = cand; if (cnt == 256) done = true; }
            if (__all(done)) break;
        }
    }
    int res0 = 0, res1 = 0;
#pragma unroll
    for (int jb = 0; jb < 4; ++jb) if (jb * 16 < ntile) {
#pragma unroll
        for (int j = jb * 16; j < jb * 16 + 16; ++j) {
            const unsigned long long bm = __ballot(keys[j] >= T);
            res0 = (lane == j) ? (int)(unsigned)bm : res0;
            res1 = (lane == j) ? (int)(unsigned)(bm >> 32) : res1;
        } }
    F.MASK[(brow + t0) * 64 + lane] = (unsigned)res0;
    F.MASK[(brow + t0 + 1) * 64 + lane] = (unsigned)res1;
}

#define KSWZ(row, colB) ((row) * 256 + ((colB) ^ (((row) & 7) << 4)))
__device__ __forceinline__ int v_st(int k, int c) { const int kk = (k & ~0xC) | ((k & 4) << 1) | ((k & 8) >> 1); return ((kk >> 3) * 4 + (c >> 5)) * 512 + ((kk & 7) * 32 + (c & 31)) * 2; }
__device__ __forceinline__ int v_rd_base(int lane) { return ((lane & 3) << 3) | (((lane >> 2) & 3) << 6) | (((lane >> 4) & 1) << 5) | (((lane >> 5) & 1) << 8); }
constexpr int v_rd_off(int d0, int ks, int half) { return d0 * 512 + ks * 4096 + half * 2048; }
constexpr int AT_V = 0, AT_K = 32768, AT_Q = 65536, AT_SCR = RING_BYTES + 1024;
static_assert(AT_Q + 8 * 8192 <= RING_BYTES && AT_SCR >= MISC_OFF + 128 && AT_SCR + 2048 <= LDS_BYTES, "attention LDS map");

__device__ __forceinline__ void attn_block(Frame& F, int b, int h, int qb) {
    const int tid = F.tid, lane = F.lane, wid = F.wave, r32 = lane & 31, hi = lane >> 5;
    LAS unsigned char* V_lds = F.lds + AT_V; LAS unsigned char* K_lds = F.lds + AT_K;
    LAS float* li_l = (LAS float*)(F.lds + AT_SCR) + wid * 64; LAS float* al_l = li_l + 32;
    const size_t brow = (size_t)b * SEQ;
    const bf16* Qp = F.QKV + (brow + qb * 256) * 3072 + h * 128;
    const bf16* Kp = F.QKV + brow * 3072 + 1024 + h * 128;
    const bf16* Vp = F.QKV + brow * 3072 + 2048 + h * 128;
    const int qpos = qb * 256 + wid * 32 + r32;
    const int qlast = qb * 256 + wid * 32 + 31;
    LAS unsigned char* Q_lds = F.lds + AT_Q + wid * 8192 + r32 * 256;
#pragma unroll
    for (int d0 = 0; d0 < 8; ++d0) *(LAS bf16x8*)(Q_lds + (((2 * d0 + hi) ^ (r32 & 15)) << 4)) = *(const bf16x8*)(Qp + (size_t)(wid * 32 + r32) * 3072 + d0 * 16 + hi * 8);
    const float slope2 = __builtin_amdgcn_exp2f(-(float)(h + 1)) * LOG2E;
    const unsigned* mrow = F.MASK + (brow + qpos) * 64;
    float m_reg = -1e30f, l_reg = 0.f; f32x16 o[4] = {};
    const int vb0 = (int)(unsigned)(uintptr_t)V_lds + v_rd_base(lane);
    const int nt = 4 * (qb + 1);
    unsigned ksrc[2], vsrc[2];
#pragma unroll
    for (int i = 0; i < 2; ++i) { const int sl = (wid * 2 + i) * 64 + lane;
        { const int row = sl >> 4, cpos = sl & 15; ksrc[i] = (unsigned)(row * 6144 + ((cpos ^ (row & 7)) << 4)); }
        { const int sub = sl >> 5, w = sl & 31, kk = (sub >> 2) * 8 + (w >> 2), k = (kk & ~0xC) | ((kk & 4) << 1) | ((kk & 8) >> 1), cc = (sub & 3) * 32 + (w & 3) * 8; vsrc[i] = (unsigned)(k * 6144 + cc * 2); } }
#define AT_DMA(BUF, kb_) do { const char* kt_ = (const char*)Kp + (size_t)(kb_) * 6144; const char* vt_ = (const char*)Vp + (size_t)(kb_) * 6144; _Pragma("unroll") for (int i = 0; i < 2; ++i) { \
        unsigned ko_ = ksrc[i], vo_ = vsrc[i]; asm volatile("" : "+v"(ko_), "+v"(vo_)); \
        __builtin_amdgcn_global_load_lds((const unsigned*)(kt_ + ko_), (LAS unsigned*)(K_lds + (BUF) * 16384 + (wid * 2 + i) * 1024), 16, 0, 0); \
        __builtin_amdgcn_global_load_lds((const unsigned*)(vt_ + vo_), (LAS unsigned*)(V_lds + (BUF) * 16384 + (wid * 2 + i) * 1024), 16, 0, 0); } } while (0)
#define AT_SYNC() do { asm volatile("s_waitcnt vmcnt(0)" ::: "memory"); __syncthreads(); } while (0)
#define PK4(P, B_, OUT) do { unsigned a0 = cvt_pk_bf16(P[B_+0], P[B_+1]), a1 = cvt_pk_bf16(P[B_+2], P[B_+3]);                          \
        unsigned b0 = cvt_pk_bf16(P[B_+4], P[B_+5]), b1 = cvt_pk_bf16(P[B_+6], P[B_+7]);                                             \
        auto r0 = __builtin_amdgcn_permlane32_swap(a0, b0, false, false); auto r1 = __builtin_amdgcn_permlane32_swap(a1, b1, false, false); \
        u32x4 w = {r0[0], r1[0], r0[1], r1[1]}; OUT = __builtin_bit_cast(bf16x8, w); } while (0)
#define TRRD(dst, off) asm volatile("ds_read_b64_tr_b16 %0, %1 offset:%2" : "=&v"(dst) : "v"(vb0), "i"(off) : "memory")
#define PV_D0(BUF, d0) do { s16x4 l0, l1, l2, l3, h0, h1, h2, h3; constexpr int b_ = (BUF) * 16384 + v_rd_off(d0, 0, 0); \
        TRRD(l0, b_); TRRD(h0, b_ + 2048); TRRD(l1, b_ + 4096); TRRD(h1, b_ + 6144); TRRD(l2, b_ + 8192); TRRD(h2, b_ + 10240); TRRD(l3, b_ + 12288); TRRD(h3, b_ + 14336); \
        asm volatile("s_waitcnt lgkmcnt(0)" ::: "memory"); __builtin_amdgcn_sched_barrier(0);   \
        o[d0] = __builtin_amdgcn_mfma_f32_32x32x16_bf16(pa0, (bf16x8){l0[0], l0[1], l0[2], l0[3], h0[0], h0[1], h0[2], h0[3]}, o[d0], 0, 0, 0);   \
        o[d0] = __builtin_amdgcn_mfma_f32_32x32x16_bf16(pa1, (bf16x8){l1[0], l1[1], l1[2], l1[3], h1[0], h1[1], h1[2], h1[3]}, o[d0], 0, 0, 0);   \
        o[d0] = __builtin_amdgcn_mfma_f32_32x32x16_bf16(pa2, (bf16x8){l2[0], l2[1], l2[2], l2[3], h2[0], h2[1], h2[2], h2[3]}, o[d0], 0, 0, 0);   \
        o[d0] = __builtin_amdgcn_mfma_f32_32x32x16_bf16(pa3, (bf16x8){l3[0], l3[1], l3[2], l3[3], h3[0], h3[1], h3[2], h3[3]}, o[d0], 0, 0, 0); } while (0)
#define AT_COMPUTE(BUF, t_) do { const int kb = (t_) * 64; if (kb <= qlast) {                                                     \
            f32x16 p0, p1;                                                                                                         \
            const float base = slope2 * (float)(kb + 4 * hi - qpos);                                                               \
            _Pragma("unroll") for (int r = 0; r < 16; ++r) { const float cr = (float)((r & 3) + 8 * (r >> 2)); p0[r] = base + slope2 * cr; p1[r] = base + slope2 * (cr + 32.f); } \
            _Pragma("unroll") for (int d0 = 0; d0 < 8; ++d0) {                                                                     \
                const int cB = ((d0 & 3) * 16 + hi * 8) * 2;                                                                       \
                const LAS unsigned char* a = K_lds + (BUF) * 16384 + KSWZ(r32, cB) + (d0 >> 2) * 128;                              \
                const bf16x8 b0 = *(const LAS bf16x8*)a, b1 = *(const LAS bf16x8*)(a + 32 * 256);                                  \
                const bf16x8 qd = *(const LAS bf16x8*)(Q_lds + (((2 * d0 + hi) ^ (r32 & 15)) << 4));                               \
                p0 = __builtin_amdgcn_mfma_f32_32x32x16_bf16(b0, qd, p0, 0, 0, 0);                                                 \
                p1 = __builtin_amdgcn_mfma_f32_32x32x16_bf16(b1, qd, p1, 0, 0, 0); }                                               \
            const unsigned w0 = mw.x >> (4 * hi), w1 = mw.y >> (4 * hi);                                                           \
            const float NEG = -__builtin_inff();                                                                                   \
            _Pragma("unroll") for (int r = 0; r < 16; ++r) { const int cr = (r & 3) + 8 * (r >> 2);                                \
                if (!((w0 >> cr) & 1u)) p0[r] = NEG;                                                                               \
                if (!((w1 >> cr) & 1u)) p1[r] = NEG; }                                                                             \
            float pmax = p0[0];                                                                                                    \
            _Pragma("unroll") for (int r = 1; r < 16; ++r) pmax = fmaxf(pmax, p0[r]);                                              \
            _Pragma("unroll") for (int r = 0; r < 16; ++r) pmax = fmaxf(pmax, p1[r]);                                              \
            { auto rr = __builtin_amdgcn_permlane32_swap(__float_as_uint(pmax), __float_as_uint(pmax), false, false);              \
              pmax = fmaxf(__uint_as_float(rr[0]), __uint_as_float(rr[1])); }                                                      \
            const float mn = fmaxf(m_reg, pmax);                                                                                   \
            const float alpha = __builtin_amdgcn_exp2f(m_reg - mn);                                                                \
            m_reg = mn;                                                                                                            \
            float ps = 0.f;                                                                                                        \
            _Pragma("unroll") for (int r = 0; r < 16; ++r) { p0[r] = __builtin_amdgcn_exp2f(p0[r] - mn); p1[r] = __builtin_amdgcn_exp2f(p1[r] - mn); ps += p0[r] + p1[r]; } \
            { auto rr = __builtin_amdgcn_permlane32_swap(__float_as_uint(ps), __float_as_uint(ps), false, false);                  \
              ps = __uint_as_float(rr[0]) + __uint_as_float(rr[1]); }                                                              \
            l_reg = l_reg * alpha + ps;                                                                                            \
            if (__any(alpha < 1.f)) {                            \
                if (hi == 0) al_l[r32] = alpha;                                                                                    \
                asm volatile("s_waitcnt lgkmcnt(0)" ::: "memory");                                                                 \
                _Pragma("unroll") for (int r = 0; r < 16; ++r) { const float al = al_l[crow(r, hi)];                               \
                    _Pragma("unroll") for (int d = 0; d < 4; ++d) o[d][r] *= al; } }                                               \
            bf16x8 pa0, pa1, pa2, pa3;                                                                                             \
            PK4(p0, 0, pa0); PK4(p0, 8, pa1); PK4(p1, 0, pa2); PK4(p1, 8, pa3);                                                    \
            PV_D0(BUF, 0); PV_D0(BUF, 1); PV_D0(BUF, 2); PV_D0(BUF, 3);                                                            \
        } } while (0)
    __syncthreads();
    AT_DMA(0, 0);
    u32x2 mw;
    for (int t = 0; t < nt; t += 2) {
        AT_SYNC(); mw = *(const u32x2*)(mrow + 2 * t); AT_DMA(1, (t + 1) * 64); AT_COMPUTE(0, t);
        AT_SYNC(); mw = *(const u32x2*)(mrow + 2 * t + 2); if (t + 2 < nt) AT_DMA(0, (t + 2) * 64); AT_COMPUTE(1, t + 1);
    }
#undef AT_DMA
#undef AT_SYNC
#undef AT_COMPUTE
#undef PV_D0
#undef TRRD
#undef PK4
    if (hi == 0) li_l[r32] = l_reg;
    asm volatile("s_waitcnt lgkmcnt(0)" ::: "memory");
    unsigned char* Ow = F.YAB + (brow + qb * 256 + wid * 32) * 2048 + 1024 + h * 128;
#pragma unroll
    for (int r = 0; r < 16; ++r) { const int orow = crow(r, hi); const float rl = __builtin_amdgcn_rcpf(li_l[orow]);
#pragma unroll
        for (int d0 = 0; d0 < 4; ++d0) { const float v = o[d0][r] * rl; const float v1 = __shfl_xor(v, 1); const float v2 = __shfl_xor(v, 2), v3 = __shfl_xor(v1, 2);
            if ((r32 & 3) == 0) *(unsigned*)(Ow + (size_t)orow * 2048 + d0 * 32 + r32) = pk4_fp8(v, v1, v2, v3); } }
}

struct Args { const float* in[17]; float* out; unsigned char* ws; int ph_lo, ph_hi, li, pad; };
__global__ void __launch_bounds__(NWAVES * 64, 2) fwd(Args args) {
    extern __shared__ __attribute__((aligned(16))) unsigned char lds_raw[];
    Frame F;
    F.lds = (LAS unsigned char*)lds_raw;
    volatile LAS unsigned* MISC = (volatile LAS unsigned*)(F.lds + MISC_OFF);
    F.tid = threadIdx.x; F.lane = F.tid & 63; F.wave = __builtin_amdgcn_readfirstlane(F.tid >> 6);
    F.G = gridDim.x; { const int bx = blockIdx.x; F.vcu = (F.G % 8 == 0) ? (bx % 8) * (F.G / 8) + bx / 8 : bx; }
    unsigned char* ws = args.ws; F.ws = ws; F.ctl = (unsigned*)(ws + WS_CTL);
    F.x = args.in[0]; F.g_mix = args.in[1]; F.w_in = args.in[2]; F.conv_w = args.in[3]; F.conv_b = args.in[4]; F.w_rg_r = args.in[5]; F.b_rg_r = args.in[6];
    F.w_rg_i = args.in[7]; F.b_rg_i = args.in[8]; F.lam = args.in[9]; F.w_br_rnn = args.in[10]; F.w_br_attn = args.in[11]; F.w_out = args.in[12]; F.g_mlp = args.in[13];
    F.w_up = args.in[14]; F.w_dn = args.in[15]; F.g_fin = args.in[16]; F.out = args.out;
    F.WinT8 = ws + WS_WIN; F.WinTb = (bf16*)(ws + WS_WIN + 18 * MiB); F.WbrT = ws + WS_WBR; F.WoT = ws + WS_WO; F.WupT = ws + WS_WUP; F.WdnT = ws + WS_WDN;
    F.WrT = (bf16*)(ws + WS_WRT); F.WiT = (bf16*)(ws + WS_WRT + 131072);
    F.PA = (bf16*)(ws + WS_PA); F.QKV = (bf16*)(ws + WS_QKV); F.IQ = (bf16*)(ws + WS_IQ); F.IK = (bf16*)(ws + WS_IKW); F.IW = (bf16*)(ws + WS_IKW + 2 * MiB); F.GATES = (bf16*)(ws + WS_GATES);
    F.MIXED = ws + WS_MIXED; F.H1 = (bf16*)(ws + WS_H1); F.H2 = (bf16*)(ws + WS_H2); F.A2 = ws + WS_A2; F.ACT = ws + WS_ACT;
    F.XN = (bf16*)args.out; F.XN8 = (unsigned char*)args.out + 64 * MiB; F.YAB = (unsigned char*)args.out;
    F.MASK = (unsigned*)(ws + WS_MASK); F.TMP = (float*)(ws + WS_TMP); F.ssq1 = (float*)(F.ctl + CW_SSQ1); F.ssq2 = (float*)(F.ctl + CW_SSQ2);
    for (int u = F.tid; u < (LDS_BYTES - RING_BYTES) / 4; u += NWAVES * 64) ((LAS unsigned*)(F.lds + RING_BYTES))[u] = 0u;
    __syncthreads();
    XcdBarrier bar; bar.bar = F.ctl + CW_BAR; bar.x = 0; bar.st = nullptr;
    if (MK_N_LAUNCHES == 1) bar = xcd_barrier_post(F.ctl + CW_BAR + args.li * XCD_BAR_WORDS, MISC + 8);
#define GRID_BAR() do { if (MK_N_LAUNCHES == 1) xcd_barrier(bar); } while (0)
    const int lo = args.ph_lo, hi = args.ph_hi;
#ifndef PHASE_MASK
#define PHASE_MASK 0x1ff
#endif
#define IN(k) (((PHASE_MASK >> (k)) & 1) && lo <= (k) && (k) < hi)
#define BOTH(k) (IN(k) && IN((k) + 1))

    if (IN(0)) { p0_prologue(F); if (BOTH(0)) GRID_BAR(); }

    if (IN(1)) {
        { pg8::Gemm g{F.XN8, F.WinT8, 2048, 2048, 2048};
          EpiProj<0> E{F.PA, F.QKV, F.IQ, F.IK, F.IW, F.GATES};
          if (F.G == 256) { pg8::InprojOrder S; S.S.init(M, 9216, F.G, (int)blockIdx.x); pg8::gemm_phase<EpiProj<0>, pg8::InprojOrder, true>(F.lds, g, S, E); }
          else { pg8::StaticOrder S; S.init(M, 9216, F.G, (int)blockIdx.x); pg8::gemm_phase<EpiProj<0>, pg8::StaticOrder, true>(F.lds, g, S, E); } }
        __syncthreads();
        { pg8::Gemm g{F.XN, F.WinTb, 4096, 4096, 4096}; pg8::StaticOrder S; S.init(M, 1280, F.G, (int)blockIdx.x);
          EpiProj<1> E{F.PA, F.QKV, F.IQ, F.IK, F.IW, F.GATES};
          pg8::gemm_phase<EpiProj<1>, pg8::StaticOrder, false>(F.lds, g, S, E); }
        __syncthreads();
        if (LATE_TRANSPOSE) late_transposes(F, F.ctl + CW_LATEQ + 64 * args.li);
        if (BOTH(1)) GRID_BAR();
    }

    if (IN(2)) {
        for (int u = blockIdx.x; u < 128; u += F.G) { rnn_unit(F, u >> 4, u & 15, 0); rnn_unit(F, u >> 4, u & 15, 1); }
        volatile LAS unsigned* qslot = MISC + 16;
        for (;;) {
            __syncthreads();
            if (F.tid == 0) *qslot = __hip_atomic_fetch_add(F.ctl + CW_IDXQ + 64 * args.li, 1u, __ATOMIC_RELAXED, __HIP_MEMORY_SCOPE_AGENT);
            __syncthreads();
            const unsigned p = *qslot;
            if (p >= 1024u) break;
            const int uu = 1023 - (int)p;
            idx_unit(F, uu & 7, uu >> 3);
        }
        if (BOTH(2)) GRID_BAR();
    }

    if (IN(3)) {
        for (int p = blockIdx.x; p < 256; p += F.G) { const int bh = p >> 2, pr = p & 3;
            attn_block(F, bh >> 3, bh & 7, 7 - pr); attn_block(F, bh >> 3, bh & 7, pr); }
        if (BOTH(3)) GRID_BAR();
    }

    if (IN(4)) {
        pg8::Gemm g{F.YAB, F.WbrT, 1024, 2048, 2048}; pg8::PairOrder S; S.S.init(M, 2048, F.G, (int)blockIdx.x);
        EpiBranch E{F.GATES, F.MIXED};
        pg8::gemm_phase<EpiBranch, pg8::PairOrder, true>(F.lds, g, S, E);
        if (BOTH(4)) GRID_BAR();
    }

    if (IN(5)) {
        pg8::Gemm g{F.MIXED, F.WoT, 2048, 2048, 2048}; pg8::StaticOrder S; S.init(M, 2048, F.G, (int)blockIdx.x);
        EpiResid<true, false> E{F.x, F.H1, F.A2, F.ssq1, 1.0f / WO_SCALE};
        pg8::gemm_phase<EpiResid<true, false>, pg8::StaticOrder, true>(F.lds, g, S, E);
        if (BOTH(5)) GRID_BAR();
    }

    if (IN(6)) {
        pg8::Gemm g{F.A2, F.WupT, 2048, 2048, 2048}; pg8::StaticOrder S; S.init(M, DFF, F.G, (int)blockIdx.x);
        EpiUp E{F.ssq1, F.ACT};
        pg8::gemm_phase<EpiUp, pg8::StaticOrder, true>(F.lds, g, S, E);
        if (BOTH(6)) GRID_BAR();
    }

    if (IN(7)) {
        pg8::Gemm g{F.ACT, F.WdnT, 8192, 8192, 8192}; pg8::StaticOrder S; S.init(M, 2048, F.G, (int)blockIdx.x);
        EpiResid<false, true> E{F.H1, F.H2, nullptr, F.ssq2, 1.0f / WDN_SCALE};
        pg8::gemm_phase<EpiResid<false, true>, pg8::StaticOrder, true>(F.lds, g, S, E);
        if (BOTH(7)) GRID_BAR();
    }

    if (IN(8)) {
        const int gw = F.vcu * NWAVES + F.wave, NGW = F.G * NWAVES;
        f32x4 gv[8];
#pragma unroll
        for (int j = 0; j < 8; ++j) gv[j] = *((const f32x4*)F.g_fin + F.lane + 64 * j);
        for (int m = gw; m < M; m += NGW) {
            const float rstd = __builtin_amdgcn_rsqf(__hip_atomic_load(F.ssq2 + m, __ATOMIC_RELAXED, __HIP_MEMORY_SCOPE_AGENT) * (1.0f / D) + NORM_EPS);
            const u32x2* hr = (const u32x2*)(F.H2 + (size_t)m * D) + F.lane;
            f32x4* xr = (f32x4*)(F.out + (size_t)m * D) + F.lane;
            u32x2 hw[8];
#pragma unroll
            for (int j = 0; j < 8; ++j) hw[j] = hr[64 * j];
#pragma unroll
            for (int j = 0; j < 8; ++j) xr[64 * j] = (f32x4){bflo(hw[j].x), bfhi(hw[j].x), bflo(hw[j].y), bfhi(hw[j].y)} * rstd * gv[j];
        }
    }
#undef IN
#undef BOTH
#undef GRID_BAR
}

extern "C" void kernel_launch(void* const* d_in, const int* in_sizes, int n_in, void* d_out, int out_size, void* d_ws, size_t ws_size, hipStream_t stream) {
    static int grid = 0;
    if (grid == 0) {
        if (n_in != 17 || out_size != M * D || ws_size < WS_END) { fprintf(stderr, "kernel_launch: unexpected shapes (n_in %d, out %d, ws %zu)\n", n_in, out_size, ws_size); grid = -1; return; }
        int dev = 0, cus = 0, per_cu = 0;
        if (hipGetDevice(&dev) != hipSuccess || hipDeviceGetAttribute(&cus, hipDeviceAttributeMultiprocessorCount, dev) != hipSuccess) { grid = -1; return; }
        if (hipFuncSetAttribute((const void*)fwd, hipFuncAttributeMaxDynamicSharedMemorySize, LDS_BYTES) != hipSuccess) { fprintf(stderr, "kernel_launch: hipFuncSetAttribute failed\n"); grid = -1; return; }
        if (hipOccupancyMaxActiveBlocksPerMultiprocessor(&per_cu, (const void*)fwd, NWAVES * 64, LDS_BYTES) != hipSuccess || per_cu < 1)
            fprintf(stderr, "kernel_launch: occupancy query reports %d workgroups per CU\n", per_cu);
        (void)hipGetLastError();
        grid = cus;
    }
    if (grid < 0) return;
    if (hipMemsetAsync((char*)d_ws + WS_CTL, 0, CTL_ZERO_BYTES, stream) != hipSuccess) return;
    Args a{};
    for (int i = 0; i < 17; ++i) a.in[i] = (const float*)d_in[i];
    a.out = (float*)d_out; a.ws = (unsigned char*)d_ws; a.pad = 0;
    if (MK_N_LAUNCHES == 1 && PROBE_DUP >= 0) {
        a.ph_lo = 0; a.ph_hi = PROBE_DUP + 1; a.li = 0; hipLaunchKernelGGL(fwd, dim3(grid), dim3(NWAVES * 64), LDS_BYTES, stream, a);
        a.ph_lo = PROBE_DUP; a.ph_hi = PROBE_DUP + 1; a.li = 1; hipLaunchKernelGGL(fwd, dim3(grid), dim3(NWAVES * 64), LDS_BYTES, stream, a);
        if (PROBE_DUP + 1 < NPHASE) { a.ph_lo = PROBE_DUP + 1; a.ph_hi = NPHASE; a.li = 2; hipLaunchKernelGGL(fwd, dim3(grid), dim3(NWAVES * 64), LDS_BYTES, stream, a); }
    } else if (MK_N_LAUNCHES == 1) {
        a.ph_lo = 0; a.ph_hi = NPHASE; a.li = 0;
        hipLaunchKernelGGL(fwd, dim3(grid), dim3(NWAVES * 64), LDS_BYTES, stream, a);
    } else {
        for (int li = 0; li < NPHASE; ++li) { a.ph_lo = li; a.ph_hi = li + 1; a.li = li;
            hipLaunchKernelGGL(fwd, dim3(grid), dim3(NWAVES * 64), LDS_BYTES, stream, a); }
    }
}
```

```cpp
#include <hip/hip_runtime.h>
#include <cstdio>
#include <cstdint>

#ifndef MK_N_LAUNCHES
#define MK_N_LAUNCHES 1
#endif
#ifndef LATE_TRANSPOSE
#define LATE_TRANSPOSE 0
#endif
#ifndef PROBE_DUP
#define PROBE_DUP (-1)
#endif

#define GAS __attribute__((address_space(1)))
#define LAS __attribute__((address_space(3)))
typedef unsigned short bf16;
typedef short bf16x8 __attribute__((ext_vector_type(8)));
typedef short s16x4 __attribute__((ext_vector_type(4)));
typedef float f32x4 __attribute__((ext_vector_type(4)));
typedef float f32x2 __attribute__((ext_vector_type(2)));
typedef float f32x16 __attribute__((ext_vector_type(16)));
typedef unsigned u32x4 __attribute__((ext_vector_type(4)));
typedef unsigned u32x2 __attribute__((ext_vector_type(2)));
typedef GAS unsigned gu32;
typedef int i32x4 __attribute__((ext_vector_type(4)));
typedef int i32x8 __attribute__((ext_vector_type(8)));

constexpr int NWAVES = 8;
constexpr int BATCH = 8, SEQ = 2048, M = BATCH * SEQ, D = 2048, DFF = 8192;
constexpr int NPROJ = 10496;
constexpr float NORM_EPS = 1e-6f;
constexpr float LOG2E = 1.4426950408889634f;
constexpr float QSCALE = 0.08838834764831845f * LOG2E;
constexpr int NPHASE = 9;

constexpr size_t MiB = 1u << 20;
constexpr size_t WS_CTL = 0, CTL_ZERO_BYTES = 1 * MiB;
constexpr size_t WS_WIN = 2 * MiB;
constexpr size_t WS_WBR = 43 * MiB;
constexpr size_t WS_WO = 51 * MiB;
constexpr size_t WS_WUP = 59 * MiB;
constexpr size_t WS_WDN = 91 * MiB;
constexpr size_t WS_WRT = 123 * MiB;
constexpr size_t WS_MASK = 124 * MiB;
constexpr size_t WS_PA = 128 * MiB;
constexpr size_t WS_QKV = 192 * MiB;
constexpr size_t WS_IQ = 288 * MiB;
constexpr size_t WS_IKW = 320 * MiB;
constexpr size_t WS_GATES = 328 * MiB;
constexpr size_t WS_END = 456 * MiB;
constexpr size_t WS_H1 = 328 * MiB;
constexpr size_t WS_H2 = 392 * MiB;
constexpr size_t WS_MIXED = WS_QKV;
constexpr size_t WS_TMP = 256 * MiB;
constexpr size_t WS_A2 = WS_PA;
constexpr size_t WS_ACT = WS_QKV;
constexpr int CW_BAR = 4096;
constexpr int CW_LATEQ = 16384 + 1024;
constexpr int CW_IDXQ = 16384;
constexpr int CW_SSQ1 = 32768;
constexpr int CW_SSQ2 = 32768 + 16384;
static_assert((CW_SSQ2 + 16384) * 4 <= (int)CTL_ZERO_BYTES, "ctl");

constexpr int LDS_BYTES = 147456;
constexpr int RING_BYTES = 131072;
constexpr int MISC_OFF = RING_BYTES + 320;

__device__ __forceinline__ unsigned cvt_pk_bf16(float lo, float hi) { unsigned r; asm volatile("v_cvt_pk_bf16_f32 %0, %1, %2" : "=v"(r) : "v"(lo), "v"(hi)); return r; }
__device__ __forceinline__ unsigned pk4_fp8(float a, float b, float c, float d) { int w = 0; w = __builtin_amdgcn_cvt_pk_fp8_f32(a, b, w, false); w = __builtin_amdgcn_cvt_pk_fp8_f32(c, d, w, true); return (unsigned)w; }
constexpr float WUP_SCALE = 64.f, WDN_SCALE = 128.f, WIN_SCALE = 64.f, WBR_SCALE = 32.f, WO_SCALE = 64.f;
__device__ __forceinline__ unsigned char f2fp8(float a) { return (unsigned char)(__builtin_amdgcn_cvt_pk_fp8_f32(a, a, 0, false) & 0xff); }
__device__ __forceinline__ float bflo(unsigned w) { return __uint_as_float(w << 16); }
__device__ __forceinline__ float bfhi(unsigned w) { return __uint_as_float(w & 0xffff0000u); }
__device__ __forceinline__ float bf2f(bf16 b) { return __uint_as_float(((unsigned)b) << 16); }
__device__ __forceinline__ float fast_sigmoid(float x) { return __builtin_amdgcn_rcpf(1.0f + __builtin_amdgcn_exp2f(-LOG2E * x)); }
__device__ __forceinline__ float gelu_tanh(float x) { const float u = x + 0.044715f * x * x * x; return x * __builtin_amdgcn_rcpf(1.0f + __builtin_amdgcn_exp2f(-2.0f * 0.7978845608f * LOG2E * u)); }
__device__ __forceinline__ int crow(int r, int hi) { return (r & 3) + 8 * (r >> 2) + 4 * hi; }

namespace pg8 {
constexpr int BM = 256, BK = 64, HALF = 128, HTB = HALF * BK * 2, STAGE_BYTES = 8 * HTB, NXCD = 8, WGM = 8;
__host__ __device__ __forceinline__ int lds_byte(int r, int c) { const int st = (r >> 4) * 2 + (c >> 5), rr = r & 15, cc = c & 31, ob = rr * 64 + cc * 2; return st * 1024 + (ob ^ (((ob >> 9) & 1) << 5)); }
__host__ __device__ __forceinline__ void stage_rc(int b, int& R, int& C) { const int st = b / 1024, sb = b % 1024, swz = sb ^ (((sb >> 9) & 1) << 5); R = (st >> 1) * 16 + swz / 64; C = (st & 1) * 32 + (swz % 64) / 2; }
__host__ __device__ __forceinline__ int perm32(int rho) { const int n = rho >> 4, i = rho & 15; return 8 * (i >> 2) + 4 * n + (i & 3); }

struct Unit { int pm, pn, kh; };
struct Gemm { const void* A; const void* Bt; int Kb, lda, ldb; };

struct StaticOrder {
    int nM, nN, nwg, G, c;
    __device__ void init(int M_, int N_, int G_, int c_) { nM = M_ / BM; nN = N_ / BM; nwg = nM * nN; G = G_; c = c_; }
    __device__ bool next(int i, Unit& u) const {
        const long L = (long)i * G + c; if (L >= nwg) return false;
        int wgid = (int)L; { const int q = nwg / NXCD, r = nwg % NXCD, xcd = wgid % NXCD, off = wgid / NXCD; wgid = (xcd < r ? xcd * (q + 1) : r * (q + 1) + (xcd - r) * q) + off; }
        const int nig = WGM * nN, gid = wgid / nig, fm = gid * WGM, gsz = (nM - fm) < WGM ? (nM - fm) : WGM;
        u.pm = fm + ((wgid % nig) % gsz); u.pn = (wgid % nig) / gsz; u.kh = 0; return true;
    }
};
struct InprojOrder {
    StaticOrder S;
    __device__ bool next(int i, Unit& u) const {
        long L;
        if (i < 7) L = (long)i * 256 + S.c;
        else { if (S.c < 64) return false; const int e = (S.c - 64) + 192 * (i - 7); if (e >= 512) return false; L = 1792 + e; }
        int wgid = (int)L; { const int q = S.nwg / NXCD, r = S.nwg % NXCD, xcd = wgid % NXCD, off = wgid / NXCD; wgid = (xcd < r ? xcd * (q + 1) : r * (q + 1) + (xcd - r) * q) + off; }
        const int nig = WGM * S.nN, gid = wgid / nig, fm = gid * WGM, gsz = (S.nM - fm) < WGM ? (S.nM - fm) : WGM;
        u.pm = fm + ((wgid % nig) % gsz); u.pn = (wgid % nig) / gsz; u.kh = 0; return true;
    }
};
struct PairOrder {
    StaticOrder S;
    __device__ bool next(int i, Unit& u) const { if (!S.next(i >> 1, u)) return false; u.kh = i & 1; return true; }
};

template <class Epi, class Sched, bool FP8 = false>
__device__ __forceinline__ void gemm_phase(LAS unsigned char* lds, const Gemm g, const Sched& S, const Epi& E) {
    const int tid = threadIdx.x, wid = __builtin_amdgcn_readfirstlane(tid >> 6), lane = tid & 63, wr = wid >> 2, wc = wid & 3, fr = lane & 15, fq = lane >> 4;
    const int nt = g.Kb / (BK * 2);
    unsigned voffA[2], voffB[2];
#pragma unroll
    for (int i = 0; i < 2; ++i) { int R, C; stage_rc(tid * 16 + i * 8192, R, C); const int Rb = Epi::PERM ? ((R & ~31) + perm32(R & 31)) : R;
        voffA[i] = (unsigned)(R * g.lda + C * 2); voffB[i] = (unsigned)(Rb * g.ldb + C * 2); }
    const size_t kstep = (size_t)(BK * 2);
    const size_t hstepA = (size_t)HALF * g.lda, hstepB = (size_t)HALF * g.ldb;
    const size_t tstepA = 2 * hstepA, tstepB = 2 * hstepB, koff = (size_t)g.Kb;
    const unsigned ldsw = (unsigned)wid * 1024u;
    const int aoff = lds_byte(wr * 64 + fr, fq * 8), boff = lds_byte(wc * 32 + fr, fq * 8);
#define PG8_SA(b, h) (((b) * 2 + (h)) * HTB)
#define PG8_SB(b, h) ((4 + (b) * 2 + (h)) * HTB)
#define PG8_STAGE(bufoff, gbase, voff) do { _Pragma("unroll") for (int _i = 0; _i < 2; ++_i) \
        __builtin_amdgcn_global_load_lds((const unsigned*)((const char*)(gbase) + (voff)[_i]), (LAS unsigned*)(lds + (bufoff) + ldsw + _i * 8192), 16, 0, 0); } while (0)
#define PG8_LDA(dst, b, h) do { _Pragma("unroll") for (int m = 0; m < 4; ++m) { const i32x4 lo_ = *(const LAS i32x4*)(lds + PG8_SA(b, h) + aoff + m * 2048), hi_ = *(const LAS i32x4*)(lds + PG8_SA(b, h) + aoff + m * 2048 + 1024); \
        dst[m] = __builtin_shufflevector(lo_, hi_, 0, 1, 2, 3, 4, 5, 6, 7); } } while (0)
#define PG8_LDB(dst, b, h) do { _Pragma("unroll") for (int n = 0; n < 2; ++n) { const i32x4 lo_ = *(const LAS i32x4*)(lds + PG8_SB(b, h) + boff + n * 2048), hi_ = *(const LAS i32x4*)(lds + PG8_SB(b, h) + boff + n * 2048 + 1024); \
        dst[n] = __builtin_shufflevector(lo_, hi_, 0, 1, 2, 3, 4, 5, 6, 7); } } while (0)
#define PG8_MMA(ai, bj, At, Bt) do { __builtin_amdgcn_s_setprio(1); _Pragma("unroll") for (int m = 0; m < 4; ++m) _Pragma("unroll") for (int n = 0; n < 2; ++n) { \
        if constexpr (FP8) asm volatile("v_mfma_scale_f32_16x16x128_f8f6f4 %0, %1, %2, %0, %3, %3 op_sel_hi:[0,0,0]" : "+v"(acc[ai][bj][m][n]) : "v"(Bt[n]), "v"(At[m]), "v"(sc7f)); \
        else { acc[ai][bj][m][n] = __builtin_amdgcn_mfma_f32_16x16x32_bf16(__builtin_bit_cast(bf16x8, __builtin_shufflevector(Bt[n], Bt[n], 0, 1, 2, 3)), __builtin_bit_cast(bf16x8, __builtin_shufflevector(At[m], At[m], 0, 1, 2, 3)), acc[ai][bj][m][n], 0, 0, 0); \
               acc[ai][bj][m][n] = __builtin_amdgcn_mfma_f32_16x16x32_bf16(__builtin_bit_cast(bf16x8, __builtin_shufflevector(Bt[n], Bt[n], 4, 5, 6, 7)), __builtin_bit_cast(bf16x8, __builtin_shufflevector(At[m], At[m], 4, 5, 6, 7)), acc[ai][bj][m][n], 0, 0, 0); } } \
        __builtin_amdgcn_s_setprio(0); } while (0)
#define PG8_WAIT_V(n) asm volatile("s_waitcnt vmcnt(" #n ")" ::: "memory")
#define PG8_WAIT_L(n) asm volatile("s_waitcnt lgkmcnt(" #n ")" ::: "memory")
#define PG8_BAR __builtin_amdgcn_s_barrier()
#define PG8_SCHED __builtin_amdgcn_sched_barrier(0)
    Unit cur, nxt; int ui = 0;
    if (!S.next(0, cur)) return;
    f32x4 acc[2][2][4][2];
#pragma unroll
    for (int a = 0; a < 2; ++a)
#pragma unroll
        for (int b = 0; b < 2; ++b)
#pragma unroll
            for (int m = 0; m < 4; ++m)
#pragma unroll
                for (int n = 0; n < 2; ++n) acc[a][b][m][n] = (f32x4){0.f, 0.f, 0.f, 0.f};
    i32x8 At[4], B0[2], B1[2];
    const int sc7f = 0x7F7F7F7F;
    const char* cA = (const char*)g.A + (size_t)cur.pm * tstepA + (size_t)cur.kh * koff; const char* cB = (const char*)g.Bt + (size_t)cur.pn * tstepB + (size_t)cur.kh * koff;
    PG8_STAGE(PG8_SB(0, 0), cB, voffB); PG8_STAGE(PG8_SB(0, 1), cB + hstepB, voffB); PG8_STAGE(PG8_SA(0, 0), cA, voffA); PG8_STAGE(PG8_SA(0, 1), cA + hstepA, voffA);
    if (wr == 1) PG8_BAR;
    PG8_WAIT_V(2); PG8_BAR;
    PG8_STAGE(PG8_SB(1, 0), cB + kstep, voffB); PG8_STAGE(PG8_SA(1, 0), cA + kstep, voffA); PG8_STAGE(PG8_SB(1, 1), cB + hstepB + kstep, voffB);
    PG8_WAIT_V(6); PG8_BAR;
    for (;;) {
        const bool has_next = S.next(ui + 1, nxt);
        const char* nA = has_next ? (const char*)g.A + (size_t)nxt.pm * tstepA + (size_t)nxt.kh * koff : cA; const char* nB = has_next ? (const char*)g.Bt + (size_t)nxt.pn * tstepB + (size_t)nxt.kh * koff : cB;
        for (int t = 0; t < nt; t += 2) {
            const bool last = (t == nt - 2);
            const char* a1 = cA + (size_t)(t + 1) * kstep;
            const char* a2 = last ? nA : cA + (size_t)(t + 2) * kstep; const char* b2 = last ? nB : cB + (size_t)(t + 2) * kstep;
            const char* a3 = a2 + kstep; const char* b3 = b2 + kstep;
            PG8_LDB(B0, 0, 0); PG8_LDB(B1, 0, 1); PG8_SCHED; PG8_LDA(At, 0, 0); PG8_STAGE(PG8_SA(1, 1), a1 + hstepA, voffA);
            PG8_WAIT_V(8); PG8_WAIT_L(0); PG8_BAR; PG8_MMA(0, 0, At, B0); PG8_MMA(0, 1, At, B1); PG8_BAR; PG8_SCHED;
            PG8_LDA(At, 0, 1); PG8_STAGE(PG8_SB(0, 0), b2, voffB); PG8_STAGE(PG8_SB(0, 1), b2 + hstepB, voffB); PG8_STAGE(PG8_SA(0, 0), a2, voffA);
            PG8_WAIT_V(8); PG8_WAIT_L(0); PG8_BAR; PG8_MMA(1, 0, At, B0); PG8_MMA(1, 1, At, B1); PG8_BAR; PG8_SCHED;
            PG8_LDB(B0, 1, 0); PG8_LDB(B1, 1, 1); PG8_SCHED; PG8_LDA(At, 1, 0); PG8_STAGE(PG8_SA(0, 1), a2 + hstepA, voffA);
            PG8_WAIT_V(8); PG8_WAIT_L(0); PG8_BAR; PG8_MMA(0, 0, At, B0); PG8_MMA(0, 1, At, B1); PG8_BAR; PG8_SCHED;
            PG8_LDA(At, 1, 1); PG8_STAGE(PG8_SB(1, 0), b3, voffB); PG8_STAGE(PG8_SB(1, 1), b3 + hstepB, voffB); PG8_STAGE(PG8_SA(1, 0), a3, voffA);
            PG8_WAIT_V(8); PG8_WAIT_L(0); PG8_BAR; PG8_MMA(1, 0, At, B0); PG8_MMA(1, 1, At, B1); PG8_BAR; PG8_SCHED;
        }
        if (wr == 0) PG8_BAR;
        if constexpr (FP8) asm volatile("s_nop 15\n\ts_nop 15" ::: "memory");
        E(acc, cur, wr, wc, fr, fq);
        if (!has_next) break;
        if (!(Epi::KEEPS && cur.kh == 0)) {
#pragma unroll
        for (int a = 0; a < 2; ++a)
#pragma unroll
            for (int b = 0; b < 2; ++b)
#pragma unroll
                for (int m = 0; m < 4; ++m)
#pragma unroll
                    for (int n = 0; n < 2; ++n) acc[a][b][m][n] = (f32x4){0.f, 0.f, 0.f, 0.f};
        }
        cur = nxt; cA = nA; cB = nB; ++ui;
        if (wr == 1) PG8_BAR;
    }
    PG8_WAIT_V(0);
    PG8_BAR;
#undef PG8_SA
#undef PG8_SB
#undef PG8_STAGE
#undef PG8_LDA
#undef PG8_LDB
#undef PG8_MMA
#undef PG8_WAIT_V
#undef PG8_WAIT_L
#undef PG8_BAR
#undef PG8_SCHED
}
}

template <int MODE> struct EpiProj {
    static constexpr bool PERM = true, KEEPS = false;
    bf16 *PA, *QKV, *IQ, *IK, *IW, *GATES;
    __device__ __forceinline__ void operator()(const f32x4 (&acc)[2][2][4][2], const pg8::Unit& u, int wr, int wc, int fr, int fq) const {
        const int pn = (MODE == 0) ? (u.pn < 20 ? u.pn : u.pn + 4) : (u.pn < 4 ? 20 + u.pn : 40);
        const float asc = (MODE == 0) ? (1.0f / WIN_SCALE) : 1.0f;
        const int row0 = u.pm * 256 + wr * 64 + fr;
        if (MODE == 1 && pn == 40) {
            if (wc < 2 || (wc == 2 && fq < 2)) {
                bf16* dst = (wc < 2) ? IK + (size_t)row0 * 64 + wc * 32 + 8 * fq : IW + (size_t)row0 * 16 + 8 * fq; const int ld = (wc < 2) ? 64 : 16;
#pragma unroll
                for (int ai = 0; ai < 2; ++ai)
#pragma unroll
                    for (int m = 0; m < 4; ++m) { const f32x4 v0 = acc[ai][0][m][0], v1 = acc[ai][0][m][1];
                        u32x4 w; w.x = cvt_pk_bf16(v0[0], v0[1]); w.y = cvt_pk_bf16(v0[2], v0[3]); w.z = cvt_pk_bf16(v1[0], v1[1]); w.w = cvt_pk_bf16(v1[2], v1[3]);
                        *(u32x4*)(dst + (size_t)(ai * 128 + m * 16) * ld) = w; }
            }
            return;
        }
        bf16* base; int ldc, cofs, act;
        if (pn < 4)       { base = PA;    ldc = 2048; cofs = pn * 256;               act = 0; }
        else if (pn < 8)  { base = PA;    ldc = 2048; cofs = 1024 + (pn - 4) * 256;  act = 1; }
        else if (pn < 12) { base = QKV;   ldc = 3072; cofs = (pn - 8) * 256;         act = 3; }
        else if (pn < 20) { base = QKV;   ldc = 3072; cofs = 1024 + (pn - 12) * 256; act = 0; }
        else if (pn < 24) { base = IQ;    ldc = 1024; cofs = (pn - 20) * 256;        act = 0; }
        else              { base = GATES; ldc = 4096; cofs = (pn - 24) * 256;        act = 2; }
        const int col0 = cofs + wc * 32 + 8 * fq;
#pragma unroll
        for (int ai = 0; ai < 2; ++ai)
#pragma unroll
            for (int m = 0; m < 4; ++m) { bf16* rowp = base + (size_t)(row0 + ai * 128 + m * 16) * ldc + col0;
#pragma unroll
                for (int bj = 0; bj < 2; ++bj) { f32x4 v0 = acc[ai][bj][m][0] * asc, v1 = acc[ai][bj][m][1] * asc;
                    if (act == 1) {
#pragma unroll
                        for (int j = 0; j < 4; ++j) { v0[j] = gelu_tanh(v0[j]); v1[j] = gelu_tanh(v1[j]); } }
                    else if (act == 2) {
#pragma unroll
                        for (int j = 0; j < 4; ++j) { v0[j] = fast_sigmoid(v0[j]); v1[j] = fast_sigmoid(v1[j]); } }
                    else if (act == 3) { v0 = v0 * QSCALE; v1 = v1 * QSCALE; }
                    u32x4 w; w.x = cvt_pk_bf16(v0[0], v0[1]); w.y = cvt_pk_bf16(v0[2], v0[3]); w.z = cvt_pk_bf16(v1[0], v1[1]); w.w = cvt_pk_bf16(v1[2], v1[3]);
                    *(u32x4*)(rowp + bj * 128) = w; } }
    }
};
struct EpiBranch {
    static constexpr bool PERM = true, KEEPS = true;
    const bf16* GATES; unsigned char* MIXED;
    __device__ __forceinline__ void operator()(f32x4 (&acc)[2][2][4][2], const pg8::Unit& u, int wr, int wc, int fr, int fq) const {
        const int row0 = u.pm * 256 + wr * 64 + fr, col0 = u.pn * 256 + wc * 32 + 8 * fq;
        const bf16* gbase = GATES + col0;
#pragma unroll
        for (int ai = 0; ai < 2; ++ai) {
            u32x4 gb[4][2], ga[4][2];
#pragma unroll
            for (int m = 0; m < 4; ++m)
#pragma unroll
                for (int bj = 0; bj < 2; ++bj) { const bf16* gp = gbase + (size_t)(row0 + ai * 128 + m * 16) * 4096 + bj * 128;
                    gb[m][bj] = *(const u32x4*)(gp + 2048); if (u.kh == 0) ga[m][bj] = *(const u32x4*)gp; }
#pragma unroll
            for (int m = 0; m < 4; ++m)
#pragma unroll
                for (int bj = 0; bj < 2; ++bj) { const u32x4 g = gb[m][bj];
                    f32x4 b0 = {bflo(g.x), bfhi(g.x), bflo(g.y), bfhi(g.y)}, b1 = {bflo(g.z), bfhi(g.z), bflo(g.w), bfhi(g.w)};
                    if (u.kh == 0) { const u32x4 a = ga[m][bj];
                        const f32x4 a0 = {bflo(a.x), bfhi(a.x), bflo(a.y), bfhi(a.y)}, a1 = {bflo(a.z), bfhi(a.z), bflo(a.w), bfhi(a.w)};
#pragma unroll
                        for (int j = 0; j < 4; ++j) { acc[ai][bj][m][0][j] *= a0[j] * __builtin_amdgcn_rcpf(fmaxf(b0[j], 1e-30f)); acc[ai][bj][m][1][j] *= a1[j] * __builtin_amdgcn_rcpf(fmaxf(b1[j], 1e-30f)); }
                    } else {
                        const f32x4 v0 = acc[ai][bj][m][0] * b0 * (1.0f / WBR_SCALE), v1 = acc[ai][bj][m][1] * b1 * (1.0f / WBR_SCALE);
                        u32x2 w; w.x = pk4_fp8(v0[0], v0[1], v0[2], v0[3]); w.y = pk4_fp8(v1[0], v1[1], v1[2], v1[3]);
                        *(u32x2*)(MIXED + (size_t)(row0 + ai * 128 + m * 16) * 2048 + col0 + bj * 128) = w; }
                }
            asm volatile("" ::: "memory");
        }
    }
};
template <bool WRITE_A2, bool HIN_BF16> struct EpiResid {
    static constexpr bool PERM = false, KEEPS = false;
    const void* hin; bf16* hout; unsigned char* A2; float* ssq; float accscale;
    __device__ __forceinline__ void operator()(const f32x4 (&acc)[2][2][4][2], const pg8::Unit& u, int wr, int wc, int fr, int fq) const {
        const int row0 = u.pm * 256 + wr * 64 + fr, col0 = u.pn * 256 + wc * 32 + 4 * fq;
#pragma unroll
        for (int ai = 0; ai < 2; ++ai) {
            f32x4 hv[4][2][2];
#pragma unroll
            for (int m = 0; m < 4; ++m)
#pragma unroll
                for (int bj = 0; bj < 2; ++bj)
#pragma unroll
                    for (int n = 0; n < 2; ++n) { const size_t o = (size_t)(row0 + ai * 128 + m * 16) * 2048 + col0 + bj * 128 + n * 16;
                        if (HIN_BF16) { const u32x2 w = *(const u32x2*)((const bf16*)hin + o); hv[m][bj][n] = (f32x4){bflo(w.x), bfhi(w.x), bflo(w.y), bfhi(w.y)}; }
                        else hv[m][bj][n] = *(const f32x4*)((const float*)hin + o); }
#pragma unroll
            for (int m = 0; m < 4; ++m) { const int row = row0 + ai * 128 + m * 16; const size_t off = (size_t)row * 2048 + col0; float s = 0.f;
#pragma unroll
                for (int bj = 0; bj < 2; ++bj)
#pragma unroll
                    for (int n = 0; n < 2; ++n) { const size_t o = off + bj * 128 + n * 16;
                        const f32x4 h = hv[m][bj][n] + acc[ai][bj][m][n] * accscale;
                        u32x2 ow; ow.x = cvt_pk_bf16(h[0], h[1]); ow.y = cvt_pk_bf16(h[2], h[3]); *(u32x2*)(hout + o) = ow;
                        s += (h[0] * h[0] + h[1] * h[1]) + (h[2] * h[2] + h[3] * h[3]);
                        if (WRITE_A2) *(unsigned*)(A2 + o) = pk4_fp8(h[0], h[1], h[2], h[3]); }
                s += __shfl_xor(s, 16); s += __shfl_xor(s, 32);
                if (fq == 0) atomicAdd(ssq + row, s); }
            asm volatile("" ::: "memory");
        }
    }
};
struct EpiUp {
    static constexpr bool PERM = true, KEEPS = false;
    const float* ssq; unsigned char* ACT;
    __device__ __forceinline__ void operator()(const f32x4 (&acc)[2][2][4][2], const pg8::Unit& u, int wr, int wc, int fr, int fq) const {
        const int row0 = u.pm * 256 + wr * 64 + fr, col0 = u.pn * 256 + wc * 32 + 8 * fq;
        float rs[8];
#pragma unroll
        for (int i = 0; i < 8; ++i) rs[i] = __hip_atomic_load(ssq + row0 + (i >> 2) * 128 + (i & 3) * 16, __ATOMIC_RELAXED, __HIP_MEMORY_SCOPE_AGENT);
#pragma unroll
        for (int ai = 0; ai < 2; ++ai)
#pragma unroll
            for (int m = 0; m < 4; ++m) { const int row = row0 + ai * 128 + m * 16;
                const float rstd = __builtin_amdgcn_rsqf(rs[ai * 4 + m] * (1.0f / 2048.0f) + NORM_EPS) * (1.0f / WUP_SCALE);
                unsigned char* rowp = ACT + (size_t)row * 8192 + col0;
#pragma unroll
                for (int bj = 0; bj < 2; ++bj) { f32x4 v0 = acc[ai][bj][m][0] * rstd, v1 = acc[ai][bj][m][1] * rstd;
#pragma unroll
                    for (int j = 0; j < 4; ++j) { const float a = fmaxf(v0[j], 0.f), b = fmaxf(v1[j], 0.f); v0[j] = fminf(a * a, 448.f); v1[j] = fminf(b * b, 448.f); }
                    u32x2 w; w.x = pk4_fp8(v0[0], v0[1], v0[2], v0[3]); w.y = pk4_fp8(v1[0], v1[1], v1[2], v1[3]);
                    *(u32x2*)(rowp + bj * 128) = w; } }
    }
};

#define XB_TMO      128
#define XB_XCNT(j)  (256  + 64 * (j))
#define XB_XSUB(j)  (1280 + 64 * (j))
#define XB_XGEN(j)  (2304 + 64 * (j))
#define XB_TOP      3328
#define XB_TOPGEN   3392
#define XCD_BAR_WORDS 3456
#define XB_SPIN_CAP (1u << 18)
__device__ __forceinline__ unsigned xb_ld(unsigned* p)              { return __hip_atomic_load(p, __ATOMIC_RELAXED, __HIP_MEMORY_SCOPE_AGENT); }
__device__ __forceinline__ unsigned xb_add(unsigned* p, unsigned v) { return __hip_atomic_fetch_add(p, v, __ATOMIC_RELAXED, __HIP_MEMORY_SCOPE_AGENT); }
__device__ __forceinline__ unsigned xb_xcc_id() { return (unsigned)__builtin_amdgcn_s_getreg((3 << 11) | 20) & 0xFu; }
#define XB_SPIN(cond, bar) do { unsigned _sp = 0; while (cond) { __builtin_amdgcn_s_sleep(1); \
    if ((++_sp & 255u) == 0u) { if (xb_ld(&(bar)[XB_TMO])) break; if (_sp > XB_SPIN_CAP) { atomicAdd(&(bar)[XB_TMO], 1u); break; } } } } while (0)
struct XcdBarrier { unsigned* bar; unsigned x; volatile LAS unsigned* st; };
__device__ __forceinline__ XcdBarrier xcd_barrier_post(unsigned* bar, volatile LAS unsigned* st) {
    XcdBarrier b; b.bar = bar; b.x = xb_xcc_id(); b.st = st;
    if (threadIdx.x == 0) (void)xb_add(&bar[XB_XCNT(b.x)], 1u);
    return b;
}
__device__ __forceinline__ void xcd_barrier_complete(unsigned* bar, unsigned x, unsigned& nloc, unsigned& nx) {
    const unsigned G = gridDim.x * gridDim.y * gridDim.z;
    unsigned sum, cnt, mine, sp = 0u;
    for (;;) {
        sum = 0u; cnt = 0u; mine = 0u;
#pragma unroll
        for (unsigned j = 0; j < 16; ++j) { const unsigned c = xb_ld(&bar[XB_XCNT(j)]); sum += c; cnt += (c > 0u) ? 1u : 0u; mine = (j == x) ? c : mine; }
        if (sum == G) break;
        __builtin_amdgcn_s_sleep(1);
        if ((++sp & 255u) == 0u) { if (xb_ld(&bar[XB_TMO])) break; if (sp > XB_SPIN_CAP) { atomicAdd(&bar[XB_TMO], 1u); break; } }
    }
    nloc = mine > 0u ? mine : 1u; nx = cnt > 0u ? cnt : 1u;
}
__device__ __forceinline__ void xcd_barrier(const XcdBarrier& b) {
    asm volatile("s_waitcnt vmcnt(0)" ::: "memory");
    __syncthreads();
    if (threadIdx.x == 0) {
        unsigned* bar = b.bar;
        __builtin_amdgcn_s_waitcnt(0);
        unsigned nloc = b.st[0], nx = b.st[1];
        if (nloc == 0u) { xcd_barrier_complete(bar, b.x, nloc, nx); b.st[0] = nloc; b.st[1] = nx; }
        const unsigned old = xb_add(&bar[XB_XSUB(b.x)], 1u);
        const unsigned gen = old / nloc;
        if (old + 1u == (gen + 1u) * nloc) {
            __builtin_amdgcn_fence(__ATOMIC_RELEASE, "agent");
            asm volatile("s_waitcnt vmcnt(0)" ::: "memory");
            const unsigned og = xb_add(&bar[XB_TOP], 1u);
            const unsigned tg = og / nx;
            if (og + 1u == (tg + 1u) * nx) xb_add(&bar[XB_TOPGEN], 1u);
            else XB_SPIN(xb_ld(&bar[XB_TOPGEN]) == tg, bar);
            __builtin_amdgcn_fence(__ATOMIC_ACQUIRE, "agent");
            xb_add(&bar[XB_XGEN(b.x)], 1u);
            asm volatile("s_waitcnt vmcnt(0)" ::: "memory");
        } else {
            XB_SPIN(xb_ld(&bar[XB_XGEN(b.x)]) == gen, bar);
            __builtin_amdgcn_fence(__ATOMIC_ACQUIRE, "agent");
            asm volatile("s_waitcnt vmcnt(0)" ::: "memory");
        }
    }
    __syncthreads();
}

struct Frame {
    LAS unsigned char* lds;
    int tid, lane, wave, vcu, G;
    const float *x, *g_mix, *w_in, *conv_w, *conv_b, *w_rg_r, *b_rg_r, *w_rg_i, *b_rg_i, *lam, *w_br_rnn, *w_br_attn, *w_out, *g_mlp, *w_up, *w_dn, *g_fin;
    float* out; unsigned char* ws; unsigned* ctl;
    bf16 *WinTb, *WrT, *WiT, *PA, *QKV, *IQ, *IK, *IW, *GATES, *XN, *H1, *H2;
    unsigned char *WinT8, *XN8, *WbrT, *WoT, *WupT, *WdnT, *YAB, *MIXED, *A2, *ACT;
    unsigned* MASK; float *TMP, *ssq1, *ssq2;
};

__device__ __forceinline__ float wave_sum(float v) {
#pragma unroll
    for (int o = 1; o < 64; o <<= 1) v += __shfl_xor(v, o);
    return v;
}

__device__ __forceinline__ int win_src_col(int n) {
    if (n < 6144) return n;
    if (n < 10240) return n + 80;
    const int w = n - 10240; return w < 80 ? 6144 + w : -1;
}
template <bool F8>
__device__ __forceinline__ void transpose_item(const float* __restrict__ W, int Nsrc, int Ndst, int mapmode, void* WTv, int ldk, int kdst0, const float* kscale, float wscale, LAS float* scr, int item, int lane) {
    const int nblk = Ndst / 32, kb = item / nblk, nb = item % nblk, k0 = 64 * kb, n0 = 32 * nb;
    const int n = n0 + (lane & 31);
    const int sc = (mapmode == 0) ? n : (mapmode == 1) ? win_src_col(n < 5120 ? n : n + 1024) : win_src_col(n < 1024 ? 5120 + n : 9216 + n);
    float tv[32];
#pragma unroll
    for (int i = 0; i < 32; ++i) { const int kk = 2 * i + (lane >> 5); tv[i] = sc >= 0 ? W[(size_t)(k0 + kk) * Nsrc + sc] : 0.f; }
    if (kscale) {
#pragma unroll
        for (int i = 0; i < 32; ++i) tv[i] *= kscale[k0 + 2 * i + (lane >> 5)]; }
#pragma unroll
    for (int i = 0; i < 32; ++i) scr[(2 * i + (lane >> 5)) * 33 + (lane & 31)] = tv[i] * wscale;
    asm volatile("s_waitcnt lgkmcnt(0)" ::: "memory");
    const int c = lane & 7;
#pragma unroll
    for (int j = 0; j < 4; ++j) { const int nn = (lane >> 3) + 8 * j; const LAS float* s = scr + (8 * c) * 33 + nn;
        if (F8) { u32x2 o; o.x = pk4_fp8(s[0 * 33], s[1 * 33], s[2 * 33], s[3 * 33]); o.y = pk4_fp8(s[4 * 33], s[5 * 33], s[6 * 33], s[7 * 33]);
            *(u32x2*)((unsigned char*)WTv + (size_t)(n0 + nn) * ldk + kdst0 + k0 + 8 * c) = o; }
        else { u32x4 o; o.x = cvt_pk_bf16(s[0 * 33], s[1 * 33]); o.y = cvt_pk_bf16(s[2 * 33], s[3 * 33]); o.z = cvt_pk_bf16(s[4 * 33], s[5 * 33]); o.w = cvt_pk_bf16(s[6 * 33], s[7 * 33]);
            *(u32x4*)((bf16*)WTv + (size_t)(n0 + nn) * ldk + kdst0 + k0 + 8 * c) = o; } }
    asm volatile("s_waitcnt lgkmcnt(0)" ::: "memory");
}
constexpr int I_IN8 = 32 * (9216 / 32), I_INB = 32 * (1280 / 32), I_BR = 16 * 64, I_O = 32 * 64, I_UP = 32 * 256, I_DN = 128 * 64, I_RG = 16 * 2;
constexpr int N_LATE = 2 * I_BR + I_O + I_UP + I_DN;
__device__ __forceinline__ void late_transposes(Frame& F, unsigned* qword) {
    LAS float* scr = (LAS float*)(F.lds + F.wave * 16384);
    for (;;) {
        unsigned it = 0u;
        if (F.lane == 0) it = __hip_atomic_fetch_add(qword, 1u, __ATOMIC_RELAXED, __HIP_MEMORY_SCOPE_AGENT);
        int r = (int)__builtin_amdgcn_readfirstlane(it);
        if (r >= N_LATE) break;
        if (r < I_BR) { transpose_item<true>(F.w_br_rnn, 2048, 2048, 0, F.WbrT, 2048, 0, nullptr, WBR_SCALE, scr, r, F.lane); continue; } r -= I_BR;
        if (r < I_BR) { transpose_item<true>(F.w_br_attn, 2048, 2048, 0, F.WbrT, 2048, 1024, nullptr, WBR_SCALE, scr, r, F.lane); continue; } r -= I_BR;
        if (r < I_O)  { transpose_item<true>(F.w_out, 2048, 2048, 0, F.WoT, 2048, 0, nullptr, WO_SCALE, scr, r, F.lane); continue; } r -= I_O;
        if (r < I_UP) { transpose_item<true>(F.w_up, 8192, 8192, 0, F.WupT, 2048, 0, F.g_mlp, WUP_SCALE, scr, r, F.lane); continue; } r -= I_UP;
        transpose_item<true>(F.w_dn, 2048, 2048, 0, F.WdnT, 8192, 0, nullptr, WDN_SCALE, scr, r, F.lane);
    }
}
__device__ __forceinline__ void p0_prologue(Frame& F) {
    LAS float* scr = (LAS float*)(F.lds + F.wave * 16384);
    const int gw = F.vcu * NWAVES + F.wave, NGW = F.G * NWAVES;
    constexpr int NITEMS = I_IN8 + I_INB + 2 * I_RG + (LATE_TRANSPOSE ? 0 : N_LATE);
    for (int it = gw; it < NITEMS; it += NGW) {
        int r = it;
        if (!LATE_TRANSPOSE) {
            if (r < I_BR) { transpose_item<true>(F.w_br_rnn, 2048, 2048, 0, F.WbrT, 2048, 0, nullptr, WBR_SCALE, scr, r, F.lane); continue; } r -= I_BR;
            if (r < I_BR) { transpose_item<true>(F.w_br_attn, 2048, 2048, 0, F.WbrT, 2048, 1024, nullptr, WBR_SCALE, scr, r, F.lane); continue; } r -= I_BR;
            if (r < I_O)  { transpose_item<true>(F.w_out, 2048, 2048, 0, F.WoT, 2048, 0, nullptr, WO_SCALE, scr, r, F.lane); continue; } r -= I_O;
            if (r < I_UP) { transpose_item<true>(F.w_up, 8192, 8192, 0, F.WupT, 2048, 0, F.g_mlp, WUP_SCALE, scr, r, F.lane); continue; } r -= I_UP;
            if (r < I_DN) { transpose_item<true>(F.w_dn, 2048, 2048, 0, F.WdnT, 8192, 0, nullptr, WDN_SCALE, scr, r, F.lane); continue; } r -= I_DN;
        }
        if (r < I_IN8) { transpose_item<true>(F.w_in, 10320, 9216, 1, F.WinT8, 2048, 0, nullptr, WIN_SCALE, scr, r, F.lane); continue; } r -= I_IN8;
        if (r < I_INB) { transpose_item<false>(F.w_in, 10320, 1280, 2, F.WinTb, 2048, 0, nullptr, 1.f, scr, r, F.lane); continue; } r -= I_INB;
        if (r < I_RG) { transpose_item<false>(F.w_rg_r + (size_t)(r >> 1) * 4096, 64, 64, 0, F.WrT + (size_t)(r >> 1) * 4096, 64, 0, nullptr, 1.f, scr, r & 1, F.lane); continue; } r -= I_RG;
        transpose_item<false>(F.w_rg_i + (size_t)(r >> 1) * 4096, 64, 64, 0, F.WiT + (size_t)(r >> 1) * 4096, 64, 0, nullptr, 1.f, scr, r & 1, F.lane);
    }
    f32x4 gv[8];
#pragma unroll
    for (int j = 0; j < 8; ++j) gv[j] = *((const f32x4*)F.g_mix + F.lane + 64 * j);
    for (int m = gw; m < M; m += NGW) {
        const f32x4* xr = (const f32x4*)(F.x + (size_t)m * D) + F.lane;
        f32x4 v[8]; float s = 0.f;
#pragma unroll
        for (int j = 0; j < 8; ++j) { v[j] = xr[64 * j]; s += (v[j].x * v[j].x + v[j].y * v[j].y) + (v[j].z * v[j].z + v[j].w * v[j].w); }
        const float rstd = __builtin_amdgcn_rsqf(wave_sum(s) * (1.0f / D) + NORM_EPS);
        u32x2* o8 = (u32x2*)(F.XN + (size_t)m * D) + F.lane; unsigned* o4 = (unsigned*)(F.XN8 + (size_t)m * D) + F.lane;
#pragma unroll
        for (int j = 0; j < 8; ++j) { const f32x4 y = v[j] * rstd * gv[j]; u32x2 w; w.x = cvt_pk_bf16(y.x, y.y); w.y = cvt_pk_bf16(y.z, y.w); o8[64 * j] = w; o4[64 * j] = pk4_fp8(y.x, y.y, y.z, y.w); }
    }
}

__device__ __forceinline__ void rnn_unit(Frame& F, int b, int n, int half) {
    LAS float* XCS = (LAS float*)F.lds + F.wave * (32 * 33);
    LAS float* CW = (LAS float*)(F.lds + 8 * 4224);
    LAS f32x2* SEG = (LAS f32x2*)(F.lds + 8 * 4224 + 1280);
    LAS unsigned char* RX = F.lds + 40960 + F.wave * 5120;
    const int tid = F.tid, lane = F.lane, wave = F.wave, r32 = lane & 31, hi = lane >> 5;
    const int c0 = 64 * n, ce = c0 + 32 * half;
    __syncthreads();
    if (tid < 320) CW[tid] = (tid < 256) ? F.conv_w[(tid >> 6) * 1024 + c0 + (tid & 63)] : F.conv_b[c0 + (tid & 63)];
    const float br = F.b_rg_r[ce + r32], bi = F.b_rg_i[ce + r32];
    const float lamv = F.lam[ce + r32];
    const float sp = (-lamv > 20.f) ? -lamv : log1pf(__expf(-lamv));
    const float Kc2 = 8.0f * sp * LOG2E;
    bf16x8 Br[4], Bi[4];
#pragma unroll
    for (int ks = 0; ks < 4; ++ks) { const size_t o = (size_t)n * 4096 + (size_t)(32 * half + r32) * 64 + 8 * hi + 16 * ks;
        Br[ks] = *(const bf16x8*)(F.WrT + o); Bi[ks] = *(const bf16x8*)(F.WiT + o); }
    float hc = 0.f;
    __syncthreads();
    for (int chunk = 0; chunk < 8; ++chunk) {
        const int t = chunk * 256 + wave * 32 + r32;
        const size_t grow = (size_t)b * SEQ + t;
        const size_t orow0 = (size_t)b * SEQ + chunk * 256 + wave * 32;
        bf16 gq[16];
#pragma unroll
        for (int r = 0; r < 16; ++r) gq[r] = F.PA[(orow0 + crow(r, hi)) * 2048 + 1024 + ce + r32];
        {
            const int tw0 = chunk * 256 + wave * 32 - 3; const int q = lane & 7;
#pragma unroll
            for (int k = 0; k < 5; ++k) { const int i = 8 * k + (lane >> 3); const int tk = tw0 + i;
                u32x4 xw = {0u, 0u, 0u, 0u};
                if (tk >= 0 && i < 35) xw = *(const u32x4*)(F.PA + ((size_t)b * SEQ + tk) * 2048 + c0 + 8 * q);
                *(LAS u32x4*)(RX + i * 128 + ((q ^ ((i >> 1) & 7)) << 4)) = xw; }
            asm volatile("s_waitcnt lgkmcnt(0)" ::: "memory");
        }
        bf16x8 Af[4];
#pragma unroll
        for (int ks = 0; ks < 4; ++ks) {
            const int d0 = 8 * hi + 16 * ks;
            float xc[8];
            { const f32x4 cb0 = *(const LAS f32x4*)(CW + 256 + d0), cb1 = *(const LAS f32x4*)(CW + 256 + d0 + 4);
              xc[0] = cb0.x; xc[1] = cb0.y; xc[2] = cb0.z; xc[3] = cb0.w; xc[4] = cb1.x; xc[5] = cb1.y; xc[6] = cb1.z; xc[7] = cb1.w; }
#pragma unroll
            for (int j = 0; j < 4; ++j) {
                const int i = r32 + j;
                const u32x4 xw = *(const LAS u32x4*)(RX + i * 128 + (((hi + 2 * ks) ^ ((i >> 1) & 7)) << 4));
                const f32x4 w0 = *(const LAS f32x4*)(CW + j * 64 + d0), w1 = *(const LAS f32x4*)(CW + j * 64 + d0 + 4);
                xc[0] += w0.x * bflo(xw.x); xc[1] += w0.y * bfhi(xw.x); xc[2] += w0.z * bflo(xw.y); xc[3] += w0.w * bfhi(xw.y);
                xc[4] += w1.x * bflo(xw.z); xc[5] += w1.y * bfhi(xw.z); xc[6] += w1.z * bflo(xw.w); xc[7] += w1.w * bfhi(xw.w);
            }
            u32x4 aw; aw.x = cvt_pk_bf16(xc[0], xc[1]); aw.y = cvt_pk_bf16(xc[2], xc[3]); aw.z = cvt_pk_bf16(xc[4], xc[5]); aw.w = cvt_pk_bf16(xc[6], xc[7]);
            Af[ks] = __builtin_bit_cast(bf16x8, aw);
            if ((ks >> 1) == half) {
#pragma unroll
                for (int i = 0; i < 8; ++i) XCS[r32 * 33 + (ks & 1) * 16 + 8 * hi + i] = xc[i];
            }
        }
        f32x16 Cr = {}, Ci = {};
#pragma unroll
        for (int ks = 0; ks < 4; ++ks) { Cr = __builtin_amdgcn_mfma_f32_32x32x16_bf16(Af[ks], Br[ks], Cr, 0, 0, 0); Ci = __builtin_amdgcn_mfma_f32_32x32x16_bf16(Af[ks], Bi[ks], Ci, 0, 0, 0); }
        asm volatile("s_waitcnt lgkmcnt(0)" ::: "memory");
        float hl[16], P[16];
#pragma unroll
        for (int r = 0; r < 16; ++r) {
            const float xcv = XCS[crow(r, hi) * 33 + r32];
            const float rr = fast_sigmoid(Cr[r] + br), ii = fast_sigmoid(Ci[r] + bi);
            const float l2a = -Kc2 * rr;
            const float a = __builtin_amdgcn_exp2f(l2a);
            const float tt = 2.0f * 0.6931471805599453f * l2a;
            const float om = (tt > -0.25f) ? -tt * (1.0f + tt * (0.5f + tt * (0.16666667f + tt * (0.041666668f + tt * 0.008333334f)))) : 1.0f - a * a;
            P[r] = a; hl[r] = __builtin_amdgcn_sqrtf(fmaxf(om, 0.f)) * ii * xcv;
        }
#pragma unroll
        for (int g = 0; g < 4; ++g)
#pragma unroll
            for (int i = 1; i < 4; ++i) { hl[4 * g + i] = P[4 * g + i] * hl[4 * g + i - 1] + hl[4 * g + i]; P[4 * g + i] = P[4 * g + i] * P[4 * g + i - 1]; }
        float cown[4], qown[4]; float c = 0.f, q = 1.f;
#pragma unroll
        for (int g = 0; g < 4; ++g) {
            const float Ag = P[4 * g + 3], Hg = hl[4 * g + 3];
            const float oA = __shfl_xor(Ag, 32), oH = __shfl_xor(Hg, 32);
            const float A1 = hi ? oA : Ag, H1 = hi ? oH : Hg, A2 = hi ? Ag : oA, H2 = hi ? Hg : oH;
            const float c1 = A1 * c + H1, q1 = A1 * q;
            cown[g] = hi ? c1 : c; qown[g] = hi ? q1 : q;
            c = A2 * c1 + H2; q = A2 * q1;
        }
        if (hi == 0) SEG[(chunk & 1) * 256 + wave * 32 + r32] = (f32x2){q, c};
        __syncthreads();
        float cin = hc, my = 0.f;
#pragma unroll
        for (int w = 0; w < 8; ++w) { const f32x2 sg = SEG[(chunk & 1) * 256 + w * 32 + r32]; my = (w == wave) ? cin : my; cin = sg.x * cin + sg.y; }
        hc = cin;
#pragma unroll
        for (int r = 0; r < 16; ++r) {
            const int g = r >> 2; const float cg = cown[g] + qown[g] * my;
            const float y = (hl[r] + P[r] * cg) * bf2f(gq[r]);
            F.YAB[(orow0 + crow(r, hi)) * 2048 + ce + r32] = f2fp8(y);
        }
    }
}

__device__ __forceinline__ unsigned ord_key(float v) { const unsigned u = __float_as_uint(v); return u ^ ((unsigned)((int)u >> 31) | 0x80000000u); }
__device__ __forceinline__ void idx_unit(Frame& F, int b, int qi) {
    const int tid = F.tid, lane = F.lane, wave = F.wave, c = lane & 31, hi = lane >> 5;
    const int t0 = 16 * qi + 2 * wave, myt = t0 + hi;
    const size_t brow = (size_t)b * SEQ;
    bf16x8 Af[4];
    { const int q = (c >> 2) & 1, hh = (c & 3) + 4 * (c >> 3);
#pragma unroll
      for (int ks = 0; ks < 4; ++ks) Af[ks] = *(const bf16x8*)(F.IQ + (brow + t0 + q) * 1024 + hh * 64 + 8 * hi + 16 * ks); }
    float wv[16];
    { const u32x4 w0 = *(const u32x4*)(F.IW + (brow + myt) * 16), w1 = *(const u32x4*)(F.IW + (brow + myt) * 16 + 8);
      const float sc = 0.25f * 0.125f;
      wv[0] = bflo(w0.x) * sc; wv[1] = bfhi(w0.x) * sc; wv[2] = bflo(w0.y) * sc; wv[3] = bfhi(w0.y) * sc; wv[4] = bflo(w0.z) * sc; wv[5] = bfhi(w0.z) * sc; wv[6] = bflo(w0.w) * sc; wv[7] = bfhi(w0.w) * sc;
      wv[8] = bflo(w1.x) * sc; wv[9] = bfhi(w1.x) * sc; wv[10] = bflo(w1.y) * sc; wv[11] = bfhi(w1.y) * sc; wv[12] = bflo(w1.z) * sc; wv[13] = bfhi(w1.z) * sc; wv[14] = bflo(w1.w) * sc; wv[15] = bfhi(w1.w) * sc; }
    const int ntile = ((t0 + 1) >> 5) + 1;
    const int ntile_wg = ((16 * qi + 15) >> 5) + 1;
    int boff[4];
#pragma unroll
    for (int ks = 0; ks < 4; ++ks) boff[ks] = c * 128 + (((2 * ks + hi) ^ ((c >> 1) & 7)) << 4);
    unsigned keys[64];
#pragma unroll
    for (int j = 0; j < 64; ++j) keys[j] = 0u;
    unsigned isrc[8];
#pragma unroll
    for (int i = 0; i < 8; ++i) { const int row = (wave * 8 + i) * 8 + (lane >> 3), cpos = lane & 7; isrc[i] = (unsigned)(row * 128 + ((cpos ^ ((row >> 1) & 7)) << 4)); }
#define IDX_DMA(BUF, blk_) do { const char* kt_ = (const char*)(F.IK + (brow + (blk_) * 512) * 64); _Pragma("unroll") for (int i = 0; i < 8; ++i) { \
        unsigned io_ = isrc[i]; asm volatile("" : "+v"(io_)); \
        __builtin_amdgcn_global_load_lds((const unsigned*)(kt_ + io_), (LAS unsigned*)(F.lds + (BUF) * 65536 + (wave * 8 + i) * 1024), 16, 0, 0); } } while (0)
    IDX_DMA(0, 0);
#pragma unroll
    for (int blk = 0; blk < 4; ++blk) if (blk * 16 < ntile_wg) {
        asm volatile("s_waitcnt vmcnt(0)" ::: "memory"); __syncthreads();
        if ((blk + 1) * 16 < ntile_wg) { if (blk & 1) IDX_DMA(0, blk + 1); else IDX_DMA(1, blk + 1); }
#pragma unroll
        for (int jj = 0; jj < 16; ++jj) { const int j = blk * 16 + jj;
            if (j < ntile) {
                bf16x8 Bf[4];
#pragma unroll
                for (int ks = 0; ks < 4; ++ks) Bf[ks] = *(const LAS bf16x8*)(F.lds + (blk & 1) * 65536 + jj * 4096 + boff[ks]);
                f32x16 acc = {};
#pragma unroll
                for (int ks = 0; ks < 4; ++ks) acc = __builtin_amdgcn_mfma_f32_32x32x16_bf16(Af[ks], Bf[ks], acc, 0, 0, 0);
                float v = 0.f;
#pragma unroll
                for (int r = 0; r < 16; ++r) v += wv[r] * fmaxf(acc[r], 0.f);
                keys[j] = (32 * j + c <= myt) ? ord_key(v) : 0u;
            } }
    }
#undef IDX_DMA
    unsigned T = 1u;
    if (t0 >= 256) {
        T = 0u; bool done = false;
        for (int bit = 31; bit >= 0; --bit) {
            const unsigned cand = T | (1u << bit);
            int cnt = 0;
#pragma unroll
            for (int jb = 0; jb < 4; ++jb) if (jb * 16 < ntile) {
#pragma unroll
                for (int j = jb * 16; j < jb * 16 + 16; ++j) cnt += (keys[j] >= cand) ? 1 : 0; }
            cnt += __shfl_xor(cnt, 1); cnt += __shfl_xor(cnt, 2); cnt += __shfl_xor(cnt, 4); cnt += __shfl_xor(cnt, 8); cnt += __shfl_xor(cnt, 16);
            if (!done) { if (cnt >= 256) T = cand; if (cnt == 256) done = true; }
            if (__all(done)) break;
        }
    }
    int res0 = 0, res1 = 0;
#pragma unroll
    for (int jb = 0; jb < 4; ++jb) if (jb * 16 < ntile) {
#pragma unroll
        for (int j = jb * 16; j < jb * 16 + 16; ++j) {
            const unsigned long long bm = __ballot(keys[j] >= T);
            res0 = (lane == j) ? (int)(unsigned)bm : res0;
            res1 = (lane == j) ? (int)(unsigned)(bm >> 32) : res1;
        } }
    F.MASK[(brow + t0) * 64 + lane] = (unsigned)res0;
    F.MASK[(brow + t0 + 1) * 64 + lane] = (unsigned)res1;
}

#define KSWZ(row, colB) ((row) * 256 + ((colB) ^ (((row) & 7) << 4)))
__device__ __forceinline__ int v_st(int k, int c) { const int kk = (k & ~0xC) | ((k & 4) << 1) | ((k & 8) >> 1); return ((kk >> 3) * 4 + (c >> 5)) * 512 + ((kk & 7) * 32 + (c & 31)) * 2; }
__device__ __forceinline__ int v_rd_base(int lane) { return ((lane & 3) << 3) | (((lane >> 2) & 3) << 6) | (((lane >> 4) & 1) << 5) | (((lane >> 5) & 1) << 8); }
constexpr int v_rd_off(int d0, int ks, int half) { return d0 * 512 + ks * 4096 + half * 2048; }
constexpr int AT_V = 0, AT_K = 32768, AT_Q = 65536, AT_SCR = RING_BYTES + 1024;
static_assert(AT_Q + 8 * 8192 <= RING_BYTES && AT_SCR >= MISC_OFF + 128 && AT_SCR + 2048 <= LDS_BYTES, "attention LDS map");

__device__ __forceinline__ void attn_block(Frame& F, int b, int h, int qb) {
    const int tid = F.tid, lane = F.lane, wid = F.wave, r32 = lane & 31, hi = lane >> 5;
    LAS unsigned char* V_lds = F.lds + AT_V; LAS unsigned char* K_lds = F.lds + AT_K;
    LAS float* li_l = (LAS float*)(F.lds + AT_SCR) + wid * 64; LAS float* al_l = li_l + 32;
    const size_t brow = (size_t)b * SEQ;
    const bf16* Qp = F.QKV + (brow + qb * 256) * 3072 + h * 128;
    const bf16* Kp = F.QKV + brow * 3072 + 1024 + h * 128;
    const bf16* Vp = F.QKV + brow * 3072 + 2048 + h * 128;
    const int qpos = qb * 256 + wid * 32 + r32;
    const int qlast = qb * 256 + wid * 32 + 31;
    LAS unsigned char* Q_lds = F.lds + AT_Q + wid * 8192 + r32 * 256;
#pragma unroll
    for (int d0 = 0; d0 < 8; ++d0) *(LAS bf16x8*)(Q_lds + (((2 * d0 + hi) ^ (r32 & 15)) << 4)) = *(const bf16x8*)(Qp + (size_t)(wid * 32 + r32) * 3072 + d0 * 16 + hi * 8);
    const float slope2 = __builtin_amdgcn_exp2f(-(float)(h + 1)) * LOG2E;
    const unsigned* mrow = F.MASK + (brow + qpos) * 64;
    float m_reg = -1e30f, l_reg = 0.f; f32x16 o[4] = {};
    const int vb0 = (int)(unsigned)(uintptr_t)V_lds + v_rd_base(lane);
    const int nt = 4 * (qb + 1);
    unsigned ksrc[2], vsrc[2];
#pragma unroll
    for (int i = 0; i < 2; ++i) { const int sl = (wid * 2 + i) * 64 + lane;
        { const int row = sl >> 4, cpos = sl & 15; ksrc[i] = (unsigned)(row * 6144 + ((cpos ^ (row & 7)) << 4)); }
        { const int sub = sl >> 5, w = sl & 31, kk = (sub >> 2) * 8 + (w >> 2), k = (kk & ~0xC) | ((kk & 4) << 1) | ((kk & 8) >> 1), cc = (sub & 3) * 32 + (w & 3) * 8; vsrc[i] = (unsigned)(k * 6144 + cc * 2); } }
#define AT_DMA(BUF, kb_) do { const char* kt_ = (const char*)Kp + (size_t)(kb_) * 6144; const char* vt_ = (const char*)Vp + (size_t)(kb_) * 6144; _Pragma("unroll") for (int i = 0; i < 2; ++i) { \
        unsigned ko_ = ksrc[i], vo_ = vsrc[i]; asm volatile("" : "+v"(ko_), "+v"(vo_)); \
        __builtin_amdgcn_global_load_lds((const unsigned*)(kt_ + ko_), (LAS unsigned*)(K_lds + (BUF) * 16384 + (wid * 2 + i) * 1024), 16, 0, 0); \
        __builtin_amdgcn_global_load_lds((const unsigned*)(vt_ + vo_), (LAS unsigned*)(V_lds + (BUF) * 16384 + (wid * 2 + i) * 1024), 16, 0, 0); } } while (0)
#define AT_SYNC() do { asm volatile("s_waitcnt vmcnt(0)" ::: "memory"); __syncthreads(); } while (0)
#define PK4(P, B_, OUT) do { unsigned a0 = cvt_pk_bf16(P[B_+0], P[B_+1]), a1 = cvt_pk_bf16(P[B_+2], P[B_+3]);                          \
        unsigned b0 = cvt_pk_bf16(P[B_+4], P[B_+5]), b1 = cvt_pk_bf16(P[B_+6], P[B_+7]);                                             \
        auto r0 = __builtin_amdgcn_permlane32_swap(a0, b0, false, false); auto r1 = __builtin_amdgcn_permlane32_swap(a1, b1, false, false); \
        u32x4 w = {r0[0], r1[0], r0[1], r1[1]}; OUT = __builtin_bit_cast(bf16x8, w); } while (0)
#define TRRD(dst, off) asm volatile("ds_read_b64_tr_b16 %0, %1 offset:%2" : "=&v"(dst) : "v"(vb0), "i"(off) : "memory")
#define PV_D0(BUF, d0) do { s16x4 l0, l1, l2, l3, h0, h1, h2, h3; constexpr int b_ = (BUF) * 16384 + v_rd_off(d0, 0, 0); \
        TRRD(l0, b_); TRRD(h0, b_ + 2048); TRRD(l1, b_ + 4096); TRRD(h1, b_ + 6144); TRRD(l2, b_ + 8192); TRRD(h2, b_ + 10240); TRRD(l3, b_ + 12288); TRRD(h3, b_ + 14336); \
        asm volatile("s_waitcnt lgkmcnt(0)" ::: "memory"); __builtin_amdgcn_sched_barrier(0);   \
        o[d0] = __builtin_amdgcn_mfma_f32_32x32x16_bf16(pa0, (bf16x8){l0[0], l0[1], l0[2], l0[3], h0[0], h0[1], h0[2], h0[3]}, o[d0], 0, 0, 0);   \
        o[d0] = __builtin_amdgcn_mfma_f32_32x32x16_bf16(pa1, (bf16x8){l1[0], l1[1], l1[2], l1[3], h1[0], h1[1], h1[2], h1[3]}, o[d0], 0, 0, 0);   \
        o[d0] = __builtin_amdgcn_mfma_f32_32x32x16_bf16(pa2, (bf16x8){l2[0], l2[1], l2[2], l2[3], h2[0], h2[1], h2[2], h2[3]}, o[d0], 0, 0, 0);   \
        o[d0] = __builtin_amdgcn_mfma_f32_32x32x16_bf16(pa3, (bf16x8){l3[0], l3[1], l3[2], l3[3], h3[0], h3[1], h3[2], h3[3]}, o[d0], 0, 0, 0); } while (0)
#define AT_COMPUTE(BUF, t_) do { const int kb = (t_) * 64; if (kb <= qlast) {                                                     \
            f32x16 p0, p1;                                                                                                         \
            const float base = slope2 * (float)(kb + 4 * hi - qpos);                                                               \
            _Pragma("unroll") for (int r = 0; r < 16; ++r) { const float cr = (float)((r & 3) + 8 * (r >> 2)); p0[r] = base + slope2 * cr; p1[r] = base + slope2 * (cr + 32.f); } \
            _Pragma("unroll") for (int d0 = 0; d0 < 8; ++d0) {                                                                     \
                const int cB = ((d0 & 3) * 16 + hi * 8) * 2;                                                                       \
                const LAS unsigned char* a = K_lds + (BUF) * 16384 + KSWZ(r32, cB) + (d0 >> 2) * 128;                              \
                const bf16x8 b0 = *(const LAS bf16x8*)a, b1 = *(const LAS bf16x8*)(a + 32 * 256);                                  \
                const bf16x8 qd = *(const LAS bf16x8*)(Q_lds + (((2 * d0 + hi) ^ (r32 & 15)) << 4));                               \
                p0 = __builtin_amdgcn_mfma_f32_32x32x16_bf16(b0, qd, p0, 0, 0, 0);                                                 \
                p1 = __builtin_amdgcn_mfma_f32_32x32x16_bf16(b1, qd, p1, 0, 0, 0); }                                               \
            const unsigned w0 = mw.x >> (4 * hi), w1 = mw.y >> (4 * hi);                                                           \
            const float NEG = -__builtin_inff();                                                                                   \
            _Pragma("unroll") for (int r = 0; r < 16; ++r) { const int cr = (r & 3) + 8 * (r >> 2);                                \
                if (!((w0 >> cr) & 1u)) p0[r] = NEG;                                                                               \
                if (!((w1 >> cr) & 1u)) p1[r] = NEG; }                                                                             \
            float pmax = p0[0];                                                                                                    \
            _Pragma("unroll") for (int r = 1; r < 16; ++r) pmax = fmaxf(pmax, p0[r]);                                              \
            _Pragma("unroll") for (int r = 0; r < 16; ++r) pmax = fmaxf(pmax, p1[r]);                                              \
            { auto rr = __builtin_amdgcn_permlane32_swap(__float_as_uint(pmax), __float_as_uint(pmax), false, false);              \
              pmax = fmaxf(__uint_as_float(rr[0]), __uint_as_float(rr[1])); }                                                      \
            const float mn = fmaxf(m_reg, pmax);                                                                                   \
            const float alpha = __builtin_amdgcn_exp2f(m_reg - mn);                                                                \
            m_reg = mn;                                                                                                            \
            float ps = 0.f;                                                                                                        \
            _Pragma("unroll") for (int r = 0; r < 16; ++r) { p0[r] = __builtin_amdgcn_exp2f(p0[r] - mn); p1[r] = __builtin_amdgcn_exp2f(p1[r] - mn); ps += p0[r] + p1[r]; } \
            { auto rr = __builtin_amdgcn_permlane32_swap(__float_as_uint(ps), __float_as_uint(ps), false, false);                  \
              ps = __uint_as_float(rr[0]) + __uint_as_float(rr[1]); }                                                              \
            l_reg = l_reg * alpha + ps;                                                                                            \
            if (__any(alpha < 1.f)) {                            \
                if (hi == 0) al_l[r32] = alpha;                                                                                    \
                asm volatile("s_waitcnt lgkmcnt(0)" ::: "memory");                                                                 \
                _Pragma("unroll") for (int r = 0; r < 16; ++r) { const float al = al_l[crow(r, hi)];                               \
                    _Pragma("unroll") for (int d = 0; d < 4; ++d) o[d][r] *= al; } }                                               \
            bf16x8 pa0, pa1, pa2, pa3;                                                                                             \
            PK4(p0, 0, pa0); PK4(p0, 8, pa1); PK4(p1, 0, pa2); PK4(p1, 8, pa3);                                                    \
            PV_D0(BUF, 0); PV_D0(BUF, 1); PV_D0(BUF, 2); PV_D0(BUF, 3);                                                            \
        } } while (0)
    __syncthreads();
    AT_DMA(0, 0);
    u32x2 mw;
    for (int t = 0; t < nt; t += 2) {
        AT_SYNC(); mw = *(const u32x2*)(mrow + 2 * t); AT_DMA(1, (t + 1) * 64); AT_COMPUTE(0, t);
        AT_SYNC(); mw = *(const u32x2*)(mrow + 2 * t + 2); if (t + 2 < nt) AT_DMA(0, (t + 2) * 64); AT_COMPUTE(1, t + 1);
    }
#undef AT_DMA
#undef AT_SYNC
#undef AT_COMPUTE
#undef PV_D0
#undef TRRD
#undef PK4
    if (hi == 0) li_l[r32] = l_reg;
    asm volatile("s_waitcnt lgkmcnt(0)" ::: "memory");
    unsigned char* Ow = F.YAB + (brow + qb * 256 + wid * 32) * 2048 + 1024 + h * 128;
#pragma unroll
    for (int r = 0; r < 16; ++r) { const int orow = crow(r, hi); const float rl = __builtin_amdgcn_rcpf(li_l[orow]);
#pragma unroll
        for (int d0 = 0; d0 < 4; ++d0) { const float v = o[d0][r] * rl; const float v1 = __shfl_xor(v, 1); const float v2 = __shfl_xor(v, 2), v3 = __shfl_xor(v1, 2);
            if ((r32 & 3) == 0) *(unsigned*)(Ow + (size_t)orow * 2048 + d0 * 32 + r32) = pk4_fp8(v, v1, v2, v3); } }
}

struct Args { const float* in[17]; float* out; unsigned char* ws; int ph_lo, ph_hi, li, pad; };
__global__ void __launch_bounds__(NWAVES * 64, 2) fwd(Args args) {
    extern __shared__ __attribute__((aligned(16))) unsigned char lds_raw[];
    Frame F;
    F.lds = (LAS unsigned char*)lds_raw;
    volatile LAS unsigned* MISC = (volatile LAS unsigned*)(F.lds + MISC_OFF);
    F.tid = threadIdx.x; F.lane = F.tid & 63; F.wave = __builtin_amdgcn_readfirstlane(F.tid >> 6);
    F.G = gridDim.x; { const int bx = blockIdx.x; F.vcu = (F.G % 8 == 0) ? (bx % 8) * (F.G / 8) + bx / 8 : bx; }
    unsigned char* ws = args.ws; F.ws = ws; F.ctl = (unsigned*)(ws + WS_CTL);
    F.x = args.in[0]; F.g_mix = args.in[1]; F.w_in = args.in[2]; F.conv_w = args.in[3]; F.conv_b = args.in[4]; F.w_rg_r = args.in[5]; F.b_rg_r = args.in[6];
    F.w_rg_i = args.in[7]; F.b_rg_i = args.in[8]; F.lam = args.in[9]; F.w_br_rnn = args.in[10]; F.w_br_attn = args.in[11]; F.w_out = args.in[12]; F.g_mlp = args.in[13];
    F.w_up = args.in[14]; F.w_dn = args.in[15]; F.g_fin = args.in[16]; F.out = args.out;
    F.WinT8 = ws + WS_WIN; F.WinTb = (bf16*)(ws + WS_WIN + 18 * MiB); F.WbrT = ws + WS_WBR; F.WoT = ws + WS_WO; F.WupT = ws + WS_WUP; F.WdnT = ws + WS_WDN;
    F.WrT = (bf16*)(ws + WS_WRT); F.WiT = (bf16*)(ws + WS_WRT + 131072);
    F.PA = (bf16*)(ws + WS_PA); F.QKV = (bf16*)(ws + WS_QKV); F.IQ = (bf16*)(ws + WS_IQ); F.IK = (bf16*)(ws + WS_IKW); F.IW = (bf16*)(ws + WS_IKW + 2 * MiB); F.GATES = (bf16*)(ws + WS_GATES);
    F.MIXED = ws + WS_MIXED; F.H1 = (bf16*)(ws + WS_H1); F.H2 = (bf16*)(ws + WS_H2); F.A2 = ws + WS_A2; F.ACT = ws + WS_ACT;
    F.XN = (bf16*)args.out; F.XN8 = (unsigned char*)args.out + 64 * MiB; F.YAB = (unsigned char*)args.out;
    F.MASK = (unsigned*)(ws + WS_MASK); F.TMP = (float*)(ws + WS_TMP); F.ssq1 = (float*)(F.ctl + CW_SSQ1); F.ssq2 = (float*)(F.ctl + CW_SSQ2);
    for (int u = F.tid; u < (LDS_BYTES - RING_BYTES) / 4; u += NWAVES * 64) ((LAS unsigned*)(F.lds + RING_BYTES))[u] = 0u;
    __syncthreads();
    XcdBarrier bar; bar.bar = F.ctl + CW_BAR; bar.x = 0; bar.st = nullptr;
    if (MK_N_LAUNCHES == 1) bar = xcd_barrier_post(F.ctl + CW_BAR + args.li * XCD_BAR_WORDS, MISC + 8);
#define GRID_BAR() do { if (MK_N_LAUNCHES == 1) xcd_barrier(bar); } while (0)
    const int lo = args.ph_lo, hi = args.ph_hi;
#ifndef PHASE_MASK
#define PHASE_MASK 0x1ff
#endif
#define IN(k) (((PHASE_MASK >> (k)) & 1) && lo <= (k) && (k) < hi)
#define BOTH(k) (IN(k) && IN((k) + 1))

    if (IN(0)) { p0_prologue(F); if (BOTH(0)) GRID_BAR(); }

    if (IN(1)) {
        { pg8::Gemm g{F.XN8, F.WinT8, 2048, 2048, 2048};
          EpiProj<0> E{F.PA, F.QKV, F.IQ, F.IK, F.IW, F.GATES};
          if (F.G == 256) { pg8::InprojOrder S; S.S.init(M, 9216, F.G, (int)blockIdx.x); pg8::gemm_phase<EpiProj<0>, pg8::InprojOrder, true>(F.lds, g, S, E); }
          else { pg8::StaticOrder S; S.init(M, 9216, F.G, (int)blockIdx.x); pg8::gemm_phase<EpiProj<0>, pg8::StaticOrder, true>(F.lds, g, S, E); } }
        __syncthreads();
        { pg8::Gemm g{F.XN, F.WinTb, 4096, 4096, 4096}; pg8::StaticOrder S; S.init(M, 1280, F.G, (int)blockIdx.x);
          EpiProj<1> E{F.PA, F.QKV, F.IQ, F.IK, F.IW, F.GATES};
          pg8::gemm_phase<EpiProj<1>, pg8::StaticOrder, false>(F.lds, g, S, E); }
        __syncthreads();
        if (LATE_TRANSPOSE) late_transposes(F, F.ctl + CW_LATEQ + 64 * args.li);
        if (BOTH(1)) GRID_BAR();
    }

    if (IN(2)) {
        for (int u = blockIdx.x; u < 128; u += F.G) { rnn_unit(F, u >> 4, u & 15, 0); rnn_unit(F, u >> 4, u & 15, 1); }
        volatile LAS unsigned* qslot = MISC + 16;
        for (;;) {
            __syncthreads();
            if (F.tid == 0) *qslot = __hip_atomic_fetch_add(F.ctl + CW_IDXQ + 64 * args.li, 1u, __ATOMIC_RELAXED, __HIP_MEMORY_SCOPE_AGENT);
            __syncthreads();
            const unsigned p = *qslot;
            if (p >= 1024u) break;
            const int uu = 1023 - (int)p;
            idx_unit(F, uu & 7, uu >> 3);
        }
        if (BOTH(2)) GRID_BAR();
    }

    if (IN(3)) {
        for (int p = blockIdx.x; p < 256; p += F.G) { const int bh = p >> 2, pr = p & 3;
            attn_block(F, bh >> 3, bh & 7, 7 - pr); attn_block(F, bh >> 3, bh & 7, pr); }
        if (BOTH(3)) GRID_BAR();
    }

    if (IN(4)) {
        pg8::Gemm g{F.YAB, F.WbrT, 1024, 2048, 2048}; pg8::PairOrder S; S.S.init(M, 2048, F.G, (int)blockIdx.x);
        EpiBranch E{F.GATES, F.MIXED};
        pg8::gemm_phase<EpiBranch, pg8::PairOrder, true>(F.lds, g, S, E);
        if (BOTH(4)) GRID_BAR();
    }

    if (IN(5)) {
        pg8::Gemm g{F.MIXED, F.WoT, 2048, 2048, 2048}; pg8::StaticOrder S; S.init(M, 2048, F.G, (int)blockIdx.x);
        EpiResid<true, false> E{F.x, F.H1, F.A2, F.ssq1, 1.0f / WO_SCALE};
        pg8::gemm_phase<EpiResid<true, false>, pg8::StaticOrder, true>(F.lds, g, S, E);
        if (BOTH(5)) GRID_BAR();
    }

    if (IN(6)) {
        pg8::Gemm g{F.A2, F.WupT, 2048, 2048, 2048}; pg8::StaticOrder S; S.init(M, DFF, F.G, (int)blockIdx.x);
        EpiUp E{F.ssq1, F.ACT};
        pg8::gemm_phase<EpiUp, pg8::StaticOrder, true>(F.lds, g, S, E);
        if (BOTH(6)) GRID_BAR();
    }

    if (IN(7)) {
        pg8::Gemm g{F.ACT, F.WdnT, 8192, 8192, 8192}; pg8::StaticOrder S; S.init(M, 2048, F.G, (int)blockIdx.x);
        EpiResid<false, true> E{F.H1, F.H2, nullptr, F.ssq2, 1.0f / WDN_SCALE};
        pg8::gemm_phase<EpiResid<false, true>, pg8::StaticOrder, true>(F.lds, g, S, E);
        if (BOTH(7)) GRID_BAR();
    }

    if (IN(8)) {
        const int gw = F.vcu * NWAVES + F.wave, NGW = F.G * NWAVES;
        f32x4 gv[8];
#pragma unroll
        for (int j = 0; j < 8; ++j) gv[j] = *((const f32x4*)F.g_fin + F.lane + 64 * j);
        for (int m = gw; m < M; m += NGW) {
            const float rstd = __builtin_amdgcn_rsqf(__hip_atomic_load(F.ssq2 + m, __ATOMIC_RELAXED, __HIP_MEMORY_SCOPE_AGENT) * (1.0f / D) + NORM_EPS);
            const u32x2* hr = (const u32x2*)(F.H2 + (size_t)m * D) + F.lane;
            f32x4* xr = (f32x4*)(F.out + (size_t)m * D) + F.lane;
            u32x2 hw[8];
#pragma unroll
            for (int j = 0; j < 8; ++j) hw[j] = hr[64 * j];
#pragma unroll
            for (int j = 0; j < 8; ++j) xr[64 * j] = (f32x4){bflo(hw[j].x), bfhi(hw[j].x), bflo(hw[j].y), bfhi(hw[j].y)} * rstd * gv[j];
        }
    }
#undef IN
#undef BOTH
#undef GRID_BAR
}

extern "C" void kernel_launch(void* const* d_in, const int* in_sizes, int n_in, void* d_out, int out_size, void* d_ws, size_t ws_size, hipStream_t stream) {
    static int grid = 0;
    if (grid == 0) {
        if (n_in != 17 || out_size != M * D || ws_size < WS_END) { fprintf(stderr, "kernel_launch: unexpected shapes (n_in %d, out %d, ws %zu)\n", n_in, out_size, ws_size); grid = -1; return; }
        int dev = 0, cus = 0, per_cu = 0;
        if (hipGetDevice(&dev) != hipSuccess || hipDeviceGetAttribute(&cus, hipDeviceAttributeMultiprocessorCount, dev) != hipSuccess) { grid = -1; return; }
        if (hipFuncSetAttribute((const void*)fwd, hipFuncAttributeMaxDynamicSharedMemorySize, LDS_BYTES) != hipSuccess) { fprintf(stderr, "kernel_launch: hipFuncSetAttribute failed\n"); grid = -1; return; }
        if (hipOccupancyMaxActiveBlocksPerMultiprocessor(&per_cu, (const void*)fwd, NWAVES * 64, LDS_BYTES) != hipSuccess || per_cu < 1)
            fprintf(stderr, "kernel_launch: occupancy query reports %d workgroups per CU\n", per_cu);
        (void)hipGetLastError();
        grid = cus;
    }
    if (grid < 0) return;
    if (hipMemsetAsync((char*)d_ws + WS_CTL, 0, CTL_ZERO_BYTES, stream) != hipSuccess) return;
    Args a{};
    for (int i = 0; i < 17; ++i) a.in[i] = (const float*)d_in[i];
    a.out = (float*)d_out; a.ws = (unsigned char*)d_ws; a.pad = 0;
    if (MK_N_LAUNCHES == 1 && PROBE_DUP >= 0) {
        a.ph_lo = 0; a.ph_hi = PROBE_DUP + 1; a.li = 0; hipLaunchKernelGGL(fwd, dim3(grid), dim3(NWAVES * 64), LDS_BYTES, stream, a);
        a.ph_lo = PROBE_DUP; a.ph_hi = PROBE_DUP + 1; a.li = 1; hipLaunchKernelGGL(fwd, dim3(grid), dim3(NWAVES * 64), LDS_BYTES, stream, a);
        if (PROBE_DUP + 1 < NPHASE) { a.ph_lo = PROBE_DUP + 1; a.ph_hi = NPHASE; a.li = 2; hipLaunchKernelGGL(fwd, dim3(grid), dim3(NWAVES * 64), LDS_BYTES, stream, a); }
    } else if (MK_N_LAUNCHES == 1) {
        a.ph_lo = 0; a.ph_hi = NPHASE; a.li = 0;
        hipLaunchKernelGGL(fwd, dim3(grid), dim3(NWAVES * 64), LDS_BYTES, stream, a);
    } else {
        for (int li = 0; li < NPHASE; ++li) { a.ph_lo = li; a.ph_hi = li + 1; a.li = li;
            hipLaunchKernelGGL(fwd, dim3(grid), dim3(NWAVES * 64), LDS_BYTES, stream, a); }
    }
}
```

```cpp
#include <hip/hip_runtime.h>
#include <cstdio>
#include <cstdint>

#ifndef MK_N_LAUNCHES
#define MK_N_LAUNCHES 1
#endif
#ifndef LATE_TRANSPOSE
#define LATE_TRANSPOSE 0
#endif
#ifndef PROBE_DUP
#define PROBE_DUP (-1)
#endif

#define GAS __attribute__((address_space(1)))
#define LAS __attribute__((address_space(3)))
typedef unsigned short bf16;
typedef short bf16x8 __attribute__((ext_vector_type(8)));
typedef short s16x4 __attribute__((ext_vector_type(4)));
typedef float f32x4 __attribute__((ext_vector_type(4)));
typedef float f32x2 __attribute__((ext_vector_type(2)));
typedef float f32x16 __attribute__((ext_vector_type(16)));
typedef unsigned u32x4 __attribute__((ext_vector_type(4)));
typedef unsigned u32x2 __attribute__((ext_vector_type(2)));
typedef GAS unsigned gu32;
typedef int i32x4 __attribute__((ext_vector_type(4)));
typedef int i32x8 __attribute__((ext_vector_type(8)));

constexpr int NWAVES = 8;
constexpr int BATCH = 8, SEQ = 2048, M = BATCH * SEQ, D = 2048, DFF = 8192;
constexpr int NPROJ = 10496;
constexpr float NORM_EPS = 1e-6f;
constexpr float LOG2E = 1.4426950408889634f;
constexpr float QSCALE = 0.08838834764831845f * LOG2E;
constexpr int NPHASE = 9;

constexpr size_t MiB = 1u << 20;
constexpr size_t WS_CTL = 0, CTL_ZERO_BYTES = 1 * MiB;
constexpr size_t WS_WIN = 2 * MiB;
constexpr size_t WS_WBR = 43 * MiB;
constexpr size_t WS_WO = 51 * MiB;
constexpr size_t WS_WUP = 59 * MiB;
constexpr size_t WS_WDN = 91 * MiB;
constexpr size_t WS_WRT = 123 * MiB;
constexpr size_t WS_MASK = 124 * MiB;
constexpr size_t WS_PA = 128 * MiB;
constexpr size_t WS_QKV = 192 * MiB;
constexpr size_t WS_IQ = 288 * MiB;
constexpr size_t WS_IKW = 320 * MiB;
constexpr size_t WS_GATES = 328 * MiB;
constexpr size_t WS_END = 456 * MiB;
constexpr size_t WS_H1 = 328 * MiB;
constexpr size_t WS_H2 = 392 * MiB;
constexpr size_t WS_MIXED = WS_QKV;
constexpr size_t WS_TMP = 256 * MiB;
constexpr size_t WS_A2 = WS_PA;
constexpr size_t WS_ACT = WS_QKV;
constexpr int CW_BAR = 4096;
constexpr int CW_LATEQ = 16384 + 1024;
constexpr int CW_IDXQ = 16384;
constexpr int CW_SSQ1 = 32768;
constexpr int CW_SSQ2 = 32768 + 16384;
static_assert((CW_SSQ2 + 16384) * 4 <= (int)CTL_ZERO_BYTES, "ctl");

constexpr int LDS_BYTES = 163840;
constexpr int RING_BYTES = 131072;
constexpr int MISC_OFF = LDS_BYTES - 512;

__device__ __forceinline__ unsigned cvt_pk_bf16(float lo, float hi) { unsigned r; asm volatile("v_cvt_pk_bf16_f32 %0, %1, %2" : "=v"(r) : "v"(lo), "v"(hi)); return r; }
__device__ __forceinline__ unsigned pk4_fp8(float a, float b, float c, float d) { int w = 0; w = __builtin_amdgcn_cvt_pk_fp8_f32(a, b, w, false); w = __builtin_amdgcn_cvt_pk_fp8_f32(c, d, w, true); return (unsigned)w; }
constexpr float WUP_SCALE = 64.f, WDN_SCALE = 128.f, WIN_SCALE = 64.f, WBR_SCALE = 32.f, WO_SCALE = 64.f;
__device__ __forceinline__ unsigned char f2fp8(float a) { return (unsigned char)(__builtin_amdgcn_cvt_pk_fp8_f32(a, a, 0, false) & 0xff); }
__device__ __forceinline__ float bflo(unsigned w) { return __uint_as_float(w << 16); }
__device__ __forceinline__ float bfhi(unsigned w) { return __uint_as_float(w & 0xffff0000u); }
__device__ __forceinline__ float bf2f(bf16 b) { return __uint_as_float(((unsigned)b) << 16); }
__device__ __forceinline__ float fast_sigmoid(float x) { return __builtin_amdgcn_rcpf(1.0f + __builtin_amdgcn_exp2f(-LOG2E * x)); }
__device__ __forceinline__ float gelu_tanh(float x) { const float u = x + 0.044715f * x * x * x; return x * __builtin_amdgcn_rcpf(1.0f + __builtin_amdgcn_exp2f(-2.0f * 0.7978845608f * LOG2E * u)); }
__device__ __forceinline__ int crow(int r, int hi) { return (r & 3) + 8 * (r >> 2) + 4 * hi; }

namespace pg8 {
constexpr int BM = 256, BK = 64, HALF = 128, HTB = HALF * BK * 2, STAGE_BYTES = 8 * HTB, NXCD = 8, WGM = 8;
__host__ __device__ __forceinline__ int lds_byte(int r, int c) { const int st = (r >> 4) * 2 + (c >> 5), rr = r & 15, cc = c & 31, ob = rr * 64 + cc * 2; return st * 1024 + (ob ^ (((ob >> 9) & 1) << 5)); }
__host__ __device__ __forceinline__ void stage_rc(int b, int& R, int& C) { const int st = b / 1024, sb = b % 1024, swz = sb ^ (((sb >> 9) & 1) << 5); R = (st >> 1) * 16 + swz / 64; C = (st & 1) * 32 + (swz % 64) / 2; }
__host__ __device__ __forceinline__ int perm32(int rho) { const int n = rho >> 4, i = rho & 15; return 8 * (i >> 2) + 4 * n + (i & 3); }

struct Unit { int pm, pn, kh; };
struct Gemm { const void* A; const void* Bt; int Kb, lda, ldb; };

struct StaticOrder {
    int nM, nN, nwg, G, c;
    __device__ void init(int M_, int N_, int G_, int c_) { nM = M_ / BM; nN = N_ / BM; nwg = nM * nN; G = G_; c = c_; }
    __device__ bool next(int i, Unit& u) const {
        const long L = (long)i * G + c; if (L >= nwg) return false;
        int wgid = (int)L; { const int q = nwg / NXCD, r = nwg % NXCD, xcd = wgid % NXCD, off = wgid / NXCD; wgid = (xcd < r ? xcd * (q + 1) : r * (q + 1) + (xcd - r) * q) + off; }
        const int nig = WGM * nN, gid = wgid / nig, fm = gid * WGM, gsz = (nM - fm) < WGM ? (nM - fm) : WGM;
        u.pm = fm + ((wgid % nig) % gsz); u.pn = (wgid % nig) / gsz; u.kh = 0; return true;
    }
};
struct InprojOrder {
    StaticOrder S;
    __device__ bool next(int i, Unit& u) const {
        long L;
        if (i < 7) L = (long)i * 256 + S.c;
        else { if (S.c < 64) return false; const int e = (S.c - 64) + 192 * (i - 7); if (e >= 512) return false; L = 1792 + e; }
        int wgid = (int)L; { const int q = S.nwg / NXCD, r = S.nwg % NXCD, xcd = wgid % NXCD, off = wgid / NXCD; wgid = (xcd < r ? xcd * (q + 1) : r * (q + 1) + (xcd - r) * q) + off; }
        const int nig = WGM * S.nN, gid = wgid / nig, fm = gid * WGM, gsz = (S.nM - fm) < WGM ? (S.nM - fm) : WGM;
        u.pm = fm + ((wgid % nig) % gsz); u.pn = (wgid % nig) / gsz; u.kh = 0; return true;
    }
};
struct PairOrder {
    StaticOrder S;
    __device__ bool next(int i, Unit& u) const { if (!S.next(i >> 1, u)) return false; u.kh = i & 1; return true; }
};

template <class Epi, class Sched, bool FP8 = false>
__device__ __forceinline__ void gemm_phase(LAS unsigned char* lds, const Gemm g, const Sched& S, const Epi& E) {
    const int tid = threadIdx.x, wid = __builtin_amdgcn_readfirstlane(tid >> 6), lane = tid & 63, wr = wid >> 2, wc = wid & 3, fr = lane & 15, fq = lane >> 4;
    const int nt = g.Kb / (BK * 2);
    unsigned voffA[2], voffB[2];
#pragma unroll
    for (int i = 0; i < 2; ++i) { int R, C; stage_rc(tid * 16 + i * 8192, R, C); const int Rb = Epi::PERM ? ((R & ~31) + perm32(R & 31)) : R;
        voffA[i] = (unsigned)(R * g.lda + C * 2); voffB[i] = (unsigned)(Rb * g.ldb + C * 2); }
    const size_t kstep = (size_t)(BK * 2);
    const size_t hstepA = (size_t)HALF * g.lda, hstepB = (size_t)HALF * g.ldb;
    const size_t tstepA = 2 * hstepA, tstepB = 2 * hstepB, koff = (size_t)g.Kb;
    const unsigned ldsw = (unsigned)wid * 1024u;
    const int aoff = lds_byte(wr * 64 + fr, fq * 8), boff = lds_byte(wc * 32 + fr, fq * 8);
#define PG8_SA(b, h) (((b) * 2 + (h)) * HTB)
#define PG8_SB(b, h) ((4 + (b) * 2 + (h)) * HTB)
#define PG8_STAGE(bufoff, gbase, voff) do { _Pragma("unroll") for (int _i = 0; _i < 2; ++_i) \
        __builtin_amdgcn_global_load_lds((const unsigned*)((const char*)(gbase) + (voff)[_i]), (LAS unsigned*)(lds + (bufoff) + ldsw + _i * 8192), 16, 0, 0); } while (0)
#define PG8_LDA(dst, b, h) do { _Pragma("unroll") for (int m = 0; m < 4; ++m) { const i32x4 lo_ = *(const LAS i32x4*)(lds + PG8_SA(b, h) + aoff + m * 2048), hi_ = *(const LAS i32x4*)(lds + PG8_SA(b, h) + aoff + m * 2048 + 1024); \
        dst[m] = __builtin_shufflevector(lo_, hi_, 0, 1, 2, 3, 4, 5, 6, 7); } } while (0)
#define PG8_LDB(dst, b, h) do { _Pragma("unroll") for (int n = 0; n < 2; ++n) { const i32x4 lo_ = *(const LAS i32x4*)(lds + PG8_SB(b, h) + boff + n * 2048), hi_ = *(const LAS i32x4*)(lds + PG8_SB(b, h) + boff + n * 2048 + 1024); \
        dst[n] = __builtin_shufflevector(lo_, hi_, 0, 1, 2, 3, 4, 5, 6, 7); } } while (0)
#define PG8_MMA(ai, bj, At, Bt) do { __builtin_amdgcn_s_setprio(1); _Pragma("unroll") for (int m = 0; m < 4; ++m) _Pragma("unroll") for (int n = 0; n < 2; ++n) { \
        if constexpr (FP8) asm volatile("v_mfma_scale_f32_16x16x128_f8f6f4 %0, %1, %2, %0, %3, %3 op_sel_hi:[0,0,0]" : "+v"(acc[ai][bj][m][n]) : "v"(Bt[n]), "v"(At[m]), "v"(sc7f)); \
        else { acc[ai][bj][m][n] = __builtin_amdgcn_mfma_f32_16x16x32_bf16(__builtin_bit_cast(bf16x8, __builtin_shufflevector(Bt[n], Bt[n], 0, 1, 2, 3)), __builtin_bit_cast(bf16x8, __builtin_shufflevector(At[m], At[m], 0, 1, 2, 3)), acc[ai][bj][m][n], 0, 0, 0); \
               acc[ai][bj][m][n] = __builtin_amdgcn_mfma_f32_16x16x32_bf16(__builtin_bit_cast(bf16x8, __builtin_shufflevector(Bt[n], Bt[n], 4, 5, 6, 7)), __builtin_bit_cast(bf16x8, __builtin_shufflevector(At[m], At[m], 4, 5, 6, 7)), acc[ai][bj][m][n], 0, 0, 0); } } \
        __builtin_amdgcn_s_setprio(0); } while (0)
#define PG8_WAIT_V(n) asm volatile("s_waitcnt vmcnt(" #n ")" ::: "memory")
#define PG8_WAIT_L(n) asm volatile("s_waitcnt lgkmcnt(" #n ")" ::: "memory")
#define PG8_BAR __builtin_amdgcn_s_barrier()
#define PG8_SCHED __builtin_amdgcn_sched_barrier(0)
    Unit cur, nxt; int ui = 0;
    if (!S.next(0, cur)) return;
    f32x4 acc[2][2][4][2];
#pragma unroll
    for (int a = 0; a < 2; ++a)
#pragma unroll
        for (int b = 0; b < 2; ++b)
#pragma unroll
            for (int m = 0; m < 4; ++m)
#pragma unroll
                for (int n = 0; n < 2; ++n) acc[a][b][m][n] = (f32x4){0.f, 0.f, 0.f, 0.f};
    i32x8 At[4], B0[2], B1[2];
    const int sc7f = 0x7F7F7F7F;
    const char* cA = (const char*)g.A + (size_t)cur.pm * tstepA + (size_t)cur.kh * koff; const char* cB = (const char*)g.Bt + (size_t)cur.pn * tstepB + (size_t)cur.kh * koff;
    PG8_STAGE(PG8_SB(0, 0), cB, voffB); PG8_STAGE(PG8_SB(0, 1), cB + hstepB, voffB); PG8_STAGE(PG8_SA(0, 0), cA, voffA); PG8_STAGE(PG8_SA(0, 1), cA + hstepA, voffA);
    if (wr == 1) PG8_BAR;
    PG8_WAIT_V(2); PG8_BAR;
    PG8_STAGE(PG8_SB(1, 0), cB + kstep, voffB); PG8_STAGE(PG8_SA(1, 0), cA + kstep, voffA); PG8_STAGE(PG8_SB(1, 1), cB + hstepB + kstep, voffB);
    PG8_WAIT_V(6); PG8_BAR;
    for (;;) {
        const bool has_next = S.next(ui + 1, nxt);
        const char* nA = has_next ? (const char*)g.A + (size_t)nxt.pm * tstepA + (size_t)nxt.kh * koff : cA; const char* nB = has_next ? (const char*)g.Bt + (size_t)nxt.pn * tstepB + (size_t)nxt.kh * koff : cB;
        for (int t = 0; t < nt; t += 2) {
            const bool last = (t == nt - 2);
            const char* a1 = cA + (size_t)(t + 1) * kstep;
            const char* a2 = last ? nA : cA + (size_t)(t + 2) * kstep; const char* b2 = last ? nB : cB + (size_t)(t + 2) * kstep;
            const char* a3 = a2 + kstep; const char* b3 = b2 + kstep;
            PG8_LDB(B0, 0, 0); PG8_LDB(B1, 0, 1); PG8_SCHED; PG8_LDA(At, 0, 0); PG8_STAGE(PG8_SA(1, 1), a1 + hstepA, voffA);
            PG8_WAIT_V(8); PG8_WAIT_L(0); PG8_BAR; PG8_MMA(0, 0, At, B0); PG8_MMA(0, 1, At, B1); PG8_BAR; PG8_SCHED;
            PG8_LDA(At, 0, 1); PG8_STAGE(PG8_SB(0, 0), b2, voffB); PG8_STAGE(PG8_SB(0, 1), b2 + hstepB, voffB); PG8_STAGE(PG8_SA(0, 0), a2, voffA);
            PG8_WAIT_V(8); PG8_WAIT_L(0); PG8_BAR; PG8_MMA(1, 0, At, B0); PG8_MMA(1, 1, At, B1); PG8_BAR; PG8_SCHED;
            PG8_LDB(B0, 1, 0); PG8_LDB(B1, 1, 1); PG8_SCHED; PG8_LDA(At, 1, 0); PG8_STAGE(PG8_SA(0, 1), a2 + hstepA, voffA);
            PG8_WAIT_V(8); PG8_WAIT_L(0); PG8_BAR; PG8_MMA(0, 0, At, B0); PG8_MMA(0, 1, At, B1); PG8_BAR; PG8_SCHED;
            PG8_LDA(At, 1, 1); PG8_STAGE(PG8_SB(1, 0), b3, voffB); PG8_STAGE(PG8_SB(1, 1), b3 + hstepB, voffB); PG8_STAGE(PG8_SA(1, 0), a3, voffA);
            PG8_WAIT_V(8); PG8_WAIT_L(0); PG8_BAR; PG8_MMA(1, 0, At, B0); PG8_MMA(1, 1, At, B1); PG8_BAR; PG8_SCHED;
        }
        if (wr == 0) PG8_BAR;
        if constexpr (FP8) asm volatile("s_nop 15\n\ts_nop 15" ::: "memory");
        E(acc, cur, wr, wc, fr, fq);
        if (!has_next) break;
        if (!(Epi::KEEPS && cur.kh == 0)) {
#pragma unroll
        for (int a = 0; a < 2; ++a)
#pragma unroll
            for (int b = 0; b < 2; ++b)
#pragma unroll
                for (int m = 0; m < 4; ++m)
#pragma unroll
                    for (int n = 0; n < 2; ++n) acc[a][b][m][n] = (f32x4){0.f, 0.f, 0.f, 0.f};
        }
        cur = nxt; cA = nA; cB = nB; ++ui;
        if (wr == 1) PG8_BAR;
    }
    PG8_WAIT_V(0);
    PG8_BAR;
#undef PG8_SA
#undef PG8_SB
#undef PG8_STAGE
#undef PG8_LDA
#undef PG8_LDB
#undef PG8_MMA
#undef PG8_WAIT_V
#undef PG8_WAIT_L
#undef PG8_BAR
#undef PG8_SCHED
}
}

template <int MODE> struct EpiProj {
    static constexpr bool PERM = true, KEEPS = false;
    bf16 *PA, *QKV, *IQ, *IK, *IW, *GATES;
    __device__ __forceinline__ void operator()(const f32x4 (&acc)[2][2][4][2], const pg8::Unit& u, int wr, int wc, int fr, int fq) const {
        const int pn = (MODE == 0) ? (u.pn < 20 ? u.pn : u.pn + 4) : (u.pn < 4 ? 20 + u.pn : 40);
        const float asc = (MODE == 0) ? (1.0f / WIN_SCALE) : 1.0f;
        const int row0 = u.pm * 256 + wr * 64 + fr;
        if (MODE == 1 && pn == 40) {
            if (wc < 2 || (wc == 2 && fq < 2)) {
                bf16* dst = (wc < 2) ? IK + (size_t)row0 * 64 + wc * 32 + 8 * fq : IW + (size_t)row0 * 16 + 8 * fq; const int ld = (wc < 2) ? 64 : 16;
#pragma unroll
                for (int ai = 0; ai < 2; ++ai)
#pragma unroll
                    for (int m = 0; m < 4; ++m) { const f32x4 v0 = acc[ai][0][m][0], v1 = acc[ai][0][m][1];
                        u32x4 w; w.x = cvt_pk_bf16(v0[0], v0[1]); w.y = cvt_pk_bf16(v0[2], v0[3]); w.z = cvt_pk_bf16(v1[0], v1[1]); w.w = cvt_pk_bf16(v1[2], v1[3]);
                        *(u32x4*)(dst + (size_t)(ai * 128 + m * 16) * ld) = w; }
            }
            return;
        }
        bf16* base; int ldc, cofs, act;
        if (pn < 4)       { base = PA;    ldc = 2048; cofs = pn * 256;               act = 0; }
        else if (pn < 8)  { base = PA;    ldc = 2048; cofs = 1024 + (pn - 4) * 256;  act = 1; }
        else if (pn < 12) { base = QKV;   ldc = 3072; cofs = (pn - 8) * 256;         act = 3; }
        else if (pn < 20) { base = QKV;   ldc = 3072; cofs = 1024 + (pn - 12) * 256; act = 0; }
        else if (pn < 24) { base = IQ;    ldc = 1024; cofs = (pn - 20) * 256;        act = 0; }
        else              { base = GATES; ldc = 4096; cofs = (pn - 24) * 256;        act = 2; }
        const int col0 = cofs + wc * 32 + 8 * fq;
#pragma unroll
        for (int ai = 0; ai < 2; ++ai)
#pragma unroll
            for (int m = 0; m < 4; ++m) { bf16* rowp = base + (size_t)(row0 + ai * 128 + m * 16) * ldc + col0;
#pragma unroll
                for (int bj = 0; bj < 2; ++bj) { f32x4 v0 = acc[ai][bj][m][0] * asc, v1 = acc[ai][bj][m][1] * asc;
                    if (act == 1) {
#pragma unroll
                        for (int j = 0; j < 4; ++j) { v0[j] = gelu_tanh(v0[j]); v1[j] = gelu_tanh(v1[j]); } }
                    else if (act == 2) {
#pragma unroll
                        for (int j = 0; j < 4; ++j) { v0[j] = fast_sigmoid(v0[j]); v1[j] = fast_sigmoid(v1[j]); } }
                    else if (act == 3) { v0 = v0 * QSCALE; v1 = v1 * QSCALE; }
                    u32x4 w; w.x = cvt_pk_bf16(v0[0], v0[1]); w.y = cvt_pk_bf16(v0[2], v0[3]); w.z = cvt_pk_bf16(v1[0], v1[1]); w.w = cvt_pk_bf16(v1[2], v1[3]);
                    *(u32x4*)(rowp + bj * 128) = w; } }
    }
};
struct EpiBranch {
    static constexpr bool PERM = true, KEEPS = true;
    const bf16* GATES; unsigned char* MIXED;
    __device__ __forceinline__ void operator()(f32x4 (&acc)[2][2][4][2], const pg8::Unit& u, int wr, int wc, int fr, int fq) const {
        const int row0 = u.pm * 256 + wr * 64 + fr, col0 = u.pn * 256 + wc * 32 + 8 * fq;
        const bf16* gbase = GATES + col0;
#pragma unroll
        for (int ai = 0; ai < 2; ++ai) {
            u32x4 gb[4][2], ga[4][2];
#pragma unroll
            for (int m = 0; m < 4; ++m)
#pragma unroll
                for (int bj = 0; bj < 2; ++bj) { const bf16* gp = gbase + (size_t)(row0 + ai * 128 + m * 16) * 4096 + bj * 128;
                    gb[m][bj] = *(const u32x4*)(gp + 2048); if (u.kh == 0) ga[m][bj] = *(const u32x4*)gp; }
#pragma unroll
            for (int m = 0; m < 4; ++m)
#pragma unroll
                for (int bj = 0; bj < 2; ++bj) { const u32x4 g = gb[m][bj];
                    f32x4 b0 = {bflo(g.x), bfhi(g.x), bflo(g.y), bfhi(g.y)}, b1 = {bflo(g.z), bfhi(g.z), bflo(g.w), bfhi(g.w)};
                    if (u.kh == 0) { const u32x4 a = ga[m][bj];
                        const f32x4 a0 = {bflo(a.x), bfhi(a.x), bflo(a.y), bfhi(a.y)}, a1 = {bflo(a.z), bfhi(a.z), bflo(a.w), bfhi(a.w)};
#pragma unroll
                        for (int j = 0; j < 4; ++j) { acc[ai][bj][m][0][j] *= a0[j] * __builtin_amdgcn_rcpf(fmaxf(b0[j], 1e-30f)); acc[ai][bj][m][1][j] *= a1[j] * __builtin_amdgcn_rcpf(fmaxf(b1[j], 1e-30f)); }
                    } else {
                        const f32x4 v0 = acc[ai][bj][m][0] * b0 * (1.0f / WBR_SCALE), v1 = acc[ai][bj][m][1] * b1 * (1.0f / WBR_SCALE);
                        u32x2 w; w.x = pk4_fp8(v0[0], v0[1], v0[2], v0[3]); w.y = pk4_fp8(v1[0], v1[1], v1[2], v1[3]);
                        *(u32x2*)(MIXED + (size_t)(row0 + ai * 128 + m * 16) * 2048 + col0 + bj * 128) = w; }
                }
            asm volatile("" ::: "memory");
        }
    }
};
template <bool WRITE_A2, bool HIN_BF16> struct EpiResid {
    static constexpr bool PERM = false, KEEPS = false;
    const void* hin; bf16* hout; unsigned char* A2; float* ssq; float accscale;
    __device__ __forceinline__ void operator()(const f32x4 (&acc)[2][2][4][2], const pg8::Unit& u, int wr, int wc, int fr, int fq) const {
        const int row0 = u.pm * 256 + wr * 64 + fr, col0 = u.pn * 256 + wc * 32 + 4 * fq;
#pragma unroll
        for (int ai = 0; ai < 2; ++ai) {
            f32x4 hv[4][2][2];
#pragma unroll
            for (int m = 0; m < 4; ++m)
#pragma unroll
                for (int bj = 0; bj < 2; ++bj)
#pragma unroll
                    for (int n = 0; n < 2; ++n) { const size_t o = (size_t)(row0 + ai * 128 + m * 16) * 2048 + col0 + bj * 128 + n * 16;
                        if (HIN_BF16) { const u32x2 w = *(const u32x2*)((const bf16*)hin + o); hv[m][bj][n] = (f32x4){bflo(w.x), bfhi(w.x), bflo(w.y), bfhi(w.y)}; }
                        else hv[m][bj][n] = *(const f32x4*)((const float*)hin + o); }
#pragma unroll
            for (int m = 0; m < 4; ++m) { const int row = row0 + ai * 128 + m * 16; const size_t off = (size_t)row * 2048 + col0; float s = 0.f;
#pragma unroll
                for (int bj = 0; bj < 2; ++bj)
#pragma unroll
                    for (int n = 0; n < 2; ++n) { const size_t o = off + bj * 128 + n * 16;
                        const f32x4 h = hv[m][bj][n] + acc[ai][bj][m][n] * accscale;
                        u32x2 ow; ow.x = cvt_pk_bf16(h[0], h[1]); ow.y = cvt_pk_bf16(h[2], h[3]); *(u32x2*)(hout + o) = ow;
                        s += (h[0] * h[0] + h[1] * h[1]) + (h[2] * h[2] + h[3] * h[3]);
                        if (WRITE_A2) *(unsigned*)(A2 + o) = pk4_fp8(h[0], h[1], h[2], h[3]); }
                s += __shfl_xor(s, 16); s += __shfl_xor(s, 32);
                if (fq == 0) atomicAdd(ssq + row, s); }
            asm volatile("" ::: "memory");
        }
    }
};
struct EpiUp {
    static constexpr bool PERM = true, KEEPS = false;
    const float* ssq; unsigned char* ACT;
    __device__ __forceinline__ void operator()(const f32x4 (&acc)[2][2][4][2], const pg8::Unit& u, int wr, int wc, int fr, int fq) const {
        const int row0 = u.pm * 256 + wr * 64 + fr, col0 = u.pn * 256 + wc * 32 + 8 * fq;
        float rs[8];
#pragma unroll
        for (int i = 0; i < 8; ++i) rs[i] = __hip_atomic_load(ssq + row0 + (i >> 2) * 128 + (i & 3) * 16, __ATOMIC_RELAXED, __HIP_MEMORY_SCOPE_AGENT);
#pragma unroll
        for (int ai = 0; ai < 2; ++ai)
#pragma unroll
            for (int m = 0; m < 4; ++m) { const int row = row0 + ai * 128 + m * 16;
                const float rstd = __builtin_amdgcn_rsqf(rs[ai * 4 + m] * (1.0f / 2048.0f) + NORM_EPS) * (1.0f / WUP_SCALE);
                unsigned char* rowp = ACT + (size_t)row * 8192 + col0;
#pragma unroll
                for (int bj = 0; bj < 2; ++bj) { f32x4 v0 = acc[ai][bj][m][0] * rstd, v1 = acc[ai][bj][m][1] * rstd;
#pragma unroll
                    for (int j = 0; j < 4; ++j) { const float a = fmaxf(v0[j], 0.f), b = fmaxf(v1[j], 0.f); v0[j] = fminf(a * a, 448.f); v1[j] = fminf(b * b, 448.f); }
                    u32x2 w; w.x = pk4_fp8(v0[0], v0[1], v0[2], v0[3]); w.y = pk4_fp8(v1[0], v1[1], v1[2], v1[3]);
                    *(u32x2*)(rowp + bj * 128) = w; } }
    }
};

#define XB_TMO      128
#define XB_XCNT(j)  (256  + 64 * (j))
#define XB_XSUB(j)  (1280 + 64 * (j))
#define XB_XGEN(j)  (2304 + 64 * (j))
#define XB_TOP      3328
#define XB_TOPGEN   3392
#define XCD_BAR_WORDS 3456
#define XB_SPIN_CAP (1u << 18)
__device__ __forceinline__ unsigned xb_ld(unsigned* p)              { return __hip_atomic_load(p, __ATOMIC_RELAXED, __HIP_MEMORY_SCOPE_AGENT); }
__device__ __forceinline__ unsigned xb_add(unsigned* p, unsigned v) { return __hip_atomic_fetch_add(p, v, __ATOMIC_RELAXED, __HIP_MEMORY_SCOPE_AGENT); }
__device__ __forceinline__ unsigned xb_xcc_id() { return (unsigned)__builtin_amdgcn_s_getreg((3 << 11) | 20) & 0xFu; }
#define XB_SPIN(cond, bar) do { unsigned _sp = 0; while (cond) { __builtin_amdgcn_s_sleep(1); \
    if ((++_sp & 255u) == 0u) { if (xb_ld(&(bar)[XB_TMO])) break; if (_sp > XB_SPIN_CAP) { atomicAdd(&(bar)[XB_TMO], 1u); break; } } } } while (0)
struct XcdBarrier { unsigned* bar; unsigned x; volatile LAS unsigned* st; };
__device__ __forceinline__ XcdBarrier xcd_barrier_post(unsigned* bar, volatile LAS unsigned* st) {
    XcdBarrier b; b.bar = bar; b.x = xb_xcc_id(); b.st = st;
    if (threadIdx.x == 0) (void)xb_add(&bar[XB_XCNT(b.x)], 1u);
    return b;
}
__device__ __forceinline__ void xcd_barrier_complete(unsigned* bar, unsigned x, unsigned& nloc, unsigned& nx) {
    const unsigned G = gridDim.x * gridDim.y * gridDim.z;
    unsigned sum, cnt, mine, sp = 0u;
    for (;;) {
        sum = 0u; cnt = 0u; mine = 0u;
#pragma unroll
        for (unsigned j = 0; j < 16; ++j) { const unsigned c = xb_ld(&bar[XB_XCNT(j)]); sum += c; cnt += (c > 0u) ? 1u : 0u; mine = (j == x) ? c : mine; }
        if (sum == G) break;
        __builtin_amdgcn_s_sleep(1);
        if ((++sp & 255u) == 0u) { if (xb_ld(&bar[XB_TMO])) break; if (sp > XB_SPIN_CAP) { atomicAdd(&bar[XB_TMO], 1u); break; } }
    }
    nloc = mine > 0u ? mine : 1u; nx = cnt > 0u ? cnt : 1u;
}
__device__ __forceinline__ void xcd_barrier(const XcdBarrier& b) {
    asm volatile("s_waitcnt vmcnt(0)" ::: "memory");
    __syncthreads();
    if (threadIdx.x == 0) {
        unsigned* bar = b.bar;
        __builtin_amdgcn_s_waitcnt(0);
        unsigned nloc = b.st[0], nx = b.st[1];
        if (nloc == 0u) { xcd_barrier_complete(bar, b.x, nloc, nx); b.st[0] = nloc; b.st[1] = nx; }
        const unsigned old = xb_add(&bar[XB_XSUB(b.x)], 1u);
        const unsigned gen = old / nloc;
        if (old + 1u == (gen + 1u) * nloc) {
            __builtin_amdgcn_fence(__ATOMIC_RELEASE, "agent");
            asm volatile("s_waitcnt vmcnt(0)" ::: "memory");
            const unsigned og = xb_add(&bar[XB_TOP], 1u);
            const unsigned tg = og / nx;
            if (og + 1u == (tg + 1u) * nx) xb_add(&bar[XB_TOPGEN], 1u);
            else XB_SPIN(xb_ld(&bar[XB_TOPGEN]) == tg, bar);
            __builtin_amdgcn_fence(__ATOMIC_ACQUIRE, "agent");
            xb_add(&bar[XB_XGEN(b.x)], 1u);
            asm volatile("s_waitcnt vmcnt(0)" ::: "memory");
        } else {
            XB_SPIN(xb_ld(&bar[XB_XGEN(b.x)]) == gen, bar);
            __builtin_amdgcn_fence(__ATOMIC_ACQUIRE, "agent");
            asm volatile("s_waitcnt vmcnt(0)" ::: "memory");
        }
    }
    __syncthreads();
}

struct Frame {
    LAS unsigned char* lds;
    int tid, lane, wave, vcu, G;
    const float *x, *g_mix, *w_in, *conv_w, *conv_b, *w_rg_r, *b_rg_r, *w_rg_i, *b_rg_i, *lam, *w_br_rnn, *w_br_attn, *w_out, *g_mlp, *w_up, *w_dn, *g_fin;
    float* out; unsigned char* ws; unsigned* ctl;
    bf16 *WinTb, *WrT, *WiT, *PA, *QKV, *IQ, *IK, *IW, *GATES, *XN, *H1, *H2;
    unsigned char *WinT8, *XN8, *WbrT, *WoT, *WupT, *WdnT, *YAB, *MIXED, *A2, *ACT;
    unsigned* MASK; float *TMP, *ssq1, *ssq2;
};

__device__ __forceinline__ float wave_sum(float v) {
#pragma unroll
    for (int o = 1; o < 64; o <<= 1) v += __shfl_xor(v, o);
    return v;
}

__device__ __forceinline__ int win_src_col(int n) {
    if (n < 6144) return n;
    if (n < 10240) return n + 80;
    const int w = n - 10240; return w < 80 ? 6144 + w : -1;
}
template <bool F8>
__device__ __forceinline__ void transpose_item(const float* __restrict__ W, int Nsrc, int Ndst, int mapmode, void* WTv, int ldk, int kdst0, const float* kscale, float wscale, LAS float* scr, int item, int lane) {
    const int nblk = Ndst / 32, kb = item / nblk, nb = item % nblk, k0 = 64 * kb, n0 = 32 * nb;
    const int n = n0 + (lane & 31);
    const int sc = (mapmode == 0) ? n : (mapmode == 1) ? win_src_col(n < 5120 ? n : n + 1024) : win_src_col(n < 1024 ? 5120 + n : 9216 + n);
    float tv[32];
#pragma unroll
    for (int i = 0; i < 32; ++i) { const int kk = 2 * i + (lane >> 5); tv[i] = sc >= 0 ? W[(size_t)(k0 + kk) * Nsrc + sc] : 0.f; }
    if (kscale) {
#pragma unroll
        for (int i = 0; i < 32; ++i) tv[i] *= kscale[k0 + 2 * i + (lane >> 5)]; }
#pragma unroll
    for (int i = 0; i < 32; ++i) scr[(2 * i + (lane >> 5)) * 33 + (lane & 31)] = tv[i] * wscale;
    asm volatile("s_waitcnt lgkmcnt(0)" ::: "memory");
    const int c = lane & 7;
#pragma unroll
    for (int j = 0; j < 4; ++j) { const int nn = (lane >> 3) + 8 * j; const LAS float* s = scr + (8 * c) * 33 + nn;
        if (F8) { u32x2 o; o.x = pk4_fp8(s[0 * 33], s[1 * 33], s[2 * 33], s[3 * 33]); o.y = pk4_fp8(s[4 * 33], s[5 * 33], s[6 * 33], s[7 * 33]);
            *(u32x2*)((unsigned char*)WTv + (size_t)(n0 + nn) * ldk + kdst0 + k0 + 8 * c) = o; }
        else { u32x4 o; o.x = cvt_pk_bf16(s[0 * 33], s[1 * 33]); o.y = cvt_pk_bf16(s[2 * 33], s[3 * 33]); o.z = cvt_pk_bf16(s[4 * 33], s[5 * 33]); o.w = cvt_pk_bf16(s[6 * 33], s[7 * 33]);
            *(u32x4*)((bf16*)WTv + (size_t)(n0 + nn) * ldk + kdst0 + k0 + 8 * c) = o; } }
    asm volatile("s_waitcnt lgkmcnt(0)" ::: "memory");
}
constexpr int I_IN8 = 32 * (9216 / 32), I_INB = 32 * (1280 / 32), I_BR = 16 * 64, I_O = 32 * 64, I_UP = 32 * 256, I_DN = 128 * 64, I_RG = 16 * 2;
constexpr int N_LATE = 2 * I_BR + I_O + I_UP + I_DN;
__device__ __forceinline__ void late_transposes(Frame& F, unsigned* qword) {
    LAS float* scr = (LAS float*)(F.lds + F.wave * 16384);
    for (;;) {
        unsigned it = 0u;
        if (F.lane == 0) it = __hip_atomic_fetch_add(qword, 1u, __ATOMIC_RELAXED, __HIP_MEMORY_SCOPE_AGENT);
        int r = (int)__builtin_amdgcn_readfirstlane(it);
        if (r >= N_LATE) break;
        if (r < I_BR) { transpose_item<true>(F.w_br_rnn, 2048, 2048, 0, F.WbrT, 2048, 0, nullptr, WBR_SCALE, scr, r, F.lane); continue; } r -= I_BR;
        if (r < I_BR) { transpose_item<true>(F.w_br_attn, 2048, 2048, 0, F.WbrT, 2048, 1024, nullptr, WBR_SCALE, scr, r, F.lane); continue; } r -= I_BR;
        if (r < I_O)  { transpose_item<true>(F.w_out, 2048, 2048, 0, F.WoT, 2048, 0, nullptr, WO_SCALE, scr, r, F.lane); continue; } r -= I_O;
        if (r < I_UP) { transpose_item<true>(F.w_up, 8192, 8192, 0, F.WupT, 2048, 0, F.g_mlp, WUP_SCALE, scr, r, F.lane); continue; } r -= I_UP;
        transpose_item<true>(F.w_dn, 2048, 2048, 0, F.WdnT, 8192, 0, nullptr, WDN_SCALE, scr, r, F.lane);
    }
}
__device__ __forceinline__ void p0_prologue(Frame& F) {
    LAS float* scr = (LAS float*)(F.lds + F.wave * 16384);
    const int gw = F.vcu * NWAVES + F.wave, NGW = F.G * NWAVES;
    constexpr int NITEMS = I_IN8 + I_INB + 2 * I_RG + (LATE_TRANSPOSE ? 0 : N_LATE);
    for (int it = gw; it < NITEMS; it += NGW) {
        int r = it;
        if (!LATE_TRANSPOSE) {
            if (r < I_BR) { transpose_item<true>(F.w_br_rnn, 2048, 2048, 0, F.WbrT, 2048, 0, nullptr, WBR_SCALE, scr, r, F.lane); continue; } r -= I_BR;
            if (r < I_BR) { transpose_item<true>(F.w_br_attn, 2048, 2048, 0, F.WbrT, 2048, 1024, nullptr, WBR_SCALE, scr, r, F.lane); continue; } r -= I_BR;
            if (r < I_O)  { transpose_item<true>(F.w_out, 2048, 2048, 0, F.WoT, 2048, 0, nullptr, WO_SCALE, scr, r, F.lane); continue; } r -= I_O;
            if (r < I_UP) { transpose_item<true>(F.w_up, 8192, 8192, 0, F.WupT, 2048, 0, F.g_mlp, WUP_SCALE, scr, r, F.lane); continue; } r -= I_UP;
            if (r < I_DN) { transpose_item<true>(F.w_dn, 2048, 2048, 0, F.WdnT, 8192, 0, nullptr, WDN_SCALE, scr, r, F.lane); continue; } r -= I_DN;
        }
        if (r < I_IN8) { transpose_item<true>(F.w_in, 10320, 9216, 1, F.WinT8, 2048, 0, nullptr, WIN_SCALE, scr, r, F.lane); continue; } r -= I_IN8;
        if (r < I_INB) { transpose_item<false>(F.w_in, 10320, 1280, 2, F.WinTb, 2048, 0, nullptr, 1.f, scr, r, F.lane); continue; } r -= I_INB;
        if (r < I_RG) { transpose_item<false>(F.w_rg_r + (size_t)(r >> 1) * 4096, 64, 64, 0, F.WrT + (size_t)(r >> 1) * 4096, 64, 0, nullptr, 1.f, scr, r & 1, F.lane); continue; } r -= I_RG;
        transpose_item<false>(F.w_rg_i + (size_t)(r >> 1) * 4096, 64, 64, 0, F.WiT + (size_t)(r >> 1) * 4096, 64, 0, nullptr, 1.f, scr, r & 1, F.lane);
    }
    f32x4 gv[8];
#pragma unroll
    for (int j = 0; j < 8; ++j) gv[j] = *((const f32x4*)F.g_mix + F.lane + 64 * j);
    for (int m = gw; m < M; m += NGW) {
        const f32x4* xr = (const f32x4*)(F.x + (size_t)m * D) + F.lane;
        f32x4 v[8]; float s = 0.f;
#pragma unroll
        for (int j = 0; j < 8; ++j) { v[j] = xr[64 * j]; s += (v[j].x * v[j].x + v[j].y * v[j].y) + (v[j].z * v[j].z + v[j].w * v[j].w); }
        const float rstd = __builtin_amdgcn_rsqf(wave_sum(s) * (1.0f / D) + NORM_EPS);
        u32x2* o8 = (u32x2*)(F.XN + (size_t)m * D) + F.lane; unsigned* o4 = (unsigned*)(F.XN8 + (size_t)m * D) + F.lane;
#pragma unroll
        for (int j = 0; j < 8; ++j) { const f32x4 y = v[j] * rstd * gv[j]; u32x2 w; w.x = cvt_pk_bf16(y.x, y.y); w.y = cvt_pk_bf16(y.z, y.w); o8[64 * j] = w; o4[64 * j] = pk4_fp8(y.x, y.y, y.z, y.w); }
    }
}

__device__ __forceinline__ void rnn_unit(Frame& F, int b, int n, int half) {
    LAS float* XCS = (LAS float*)F.lds + F.wave * (32 * 33);
    LAS float* CW = (LAS float*)(F.lds + 8 * 4224);
    LAS f32x2* SEG = (LAS f32x2*)(F.lds + 8 * 4224 + 1280);
    LAS unsigned char* RX = F.lds + 40960 + F.wave * 5120;
    const int tid = F.tid, lane = F.lane, wave = F.wave, r32 = lane & 31, hi = lane >> 5;
    const int c0 = 64 * n, ce = c0 + 32 * half;
    __syncthreads();
    if (tid < 320) CW[tid] = (tid < 256) ? F.conv_w[(tid >> 6) * 1024 + c0 + (tid & 63)] : F.conv_b[c0 + (tid & 63)];
    const float br = F.b_rg_r[ce + r32], bi = F.b_rg_i[ce + r32];
    const float lamv = F.lam[ce + r32];
    const float sp = (-lamv > 20.f) ? -lamv : log1pf(__expf(-lamv));
    const float Kc2 = 8.0f * sp * LOG2E;
    bf16x8 Br[4], Bi[4];
#pragma unroll
    for (int ks = 0; ks < 4; ++ks) { const size_t o = (size_t)n * 4096 + (size_t)(32 * half + r32) * 64 + 8 * hi + 16 * ks;
        Br[ks] = *(const bf16x8*)(F.WrT + o); Bi[ks] = *(const bf16x8*)(F.WiT + o); }
    float hc = 0.f;
    __syncthreads();
    for (int chunk = 0; chunk < 8; ++chunk) {
        const int t = chunk * 256 + wave * 32 + r32;
        const size_t grow = (size_t)b * SEQ + t;
        const size_t orow0 = (size_t)b * SEQ + chunk * 256 + wave * 32;
        bf16 gq[16];
#pragma unroll
        for (int r = 0; r < 16; ++r) gq[r] = F.PA[(orow0 + crow(r, hi)) * 2048 + 1024 + ce + r32];
        {
            const int tw0 = chunk * 256 + wave * 32 - 3; const int q = lane & 7;
#pragma unroll
            for (int k = 0; k < 5; ++k) { const int i = 8 * k + (lane >> 3); const int tk = tw0 + i;
                u32x4 xw = {0u, 0u, 0u, 0u};
                if (tk >= 0 && i < 35) xw = *(const u32x4*)(F.PA + ((size_t)b * SEQ + tk) * 2048 + c0 + 8 * q);
                *(LAS u32x4*)(RX + i * 128 + ((q ^ ((i >> 1) & 7)) << 4)) = xw; }
            asm volatile("s_waitcnt lgkmcnt(0)" ::: "memory");
        }
        bf16x8 Af[4];
#pragma unroll
        for (int ks = 0; ks < 4; ++ks) {
            const int d0 = 8 * hi + 16 * ks;
            float xc[8];
            { const f32x4 cb0 = *(const LAS f32x4*)(CW + 256 + d0), cb1 = *(const LAS f32x4*)(CW + 256 + d0 + 4);
              xc[0] = cb0.x; xc[1] = cb0.y; xc[2] = cb0.z; xc[3] = cb0.w; xc[4] = cb1.x; xc[5] = cb1.y; xc[6] = cb1.z; xc[7] = cb1.w; }
#pragma unroll
            for (int j = 0; j < 4; ++j) {
                const int i = r32 + j;
                const u32x4 xw = *(const LAS u32x4*)(RX + i * 128 + (((hi + 2 * ks) ^ ((i >> 1) & 7)) << 4));
                const f32x4 w0 = *(const LAS f32x4*)(CW + j * 64 + d0), w1 = *(const LAS f32x4*)(CW + j * 64 + d0 + 4);
                xc[0] += w0.x * bflo(xw.x); xc[1] += w0.y * bfhi(xw.x); xc[2] += w0.z * bflo(xw.y); xc[3] += w0.w * bfhi(xw.y);
                xc[4] += w1.x * bflo(xw.z); xc[5] += w1.y * bfhi(xw.z); xc[6] += w1.z * bflo(xw.w); xc[7] += w1.w * bfhi(xw.w);
            }
            u32x4 aw; aw.x = cvt_pk_bf16(xc[0], xc[1]); aw.y = cvt_pk_bf16(xc[2], xc[3]); aw.z = cvt_pk_bf16(xc[4], xc[5]); aw.w = cvt_pk_bf16(xc[6], xc[7]);
            Af[ks] = __builtin_bit_cast(bf16x8, aw);
            if ((ks >> 1) == half) {
#pragma unroll
                for (int i = 0; i < 8; ++i) XCS[r32 * 33 + (ks & 1) * 16 + 8 * hi + i] = xc[i];
            }
        }
        f32x16 Cr = {}, Ci = {};
#pragma unroll
        for (int ks = 0; ks < 4; ++ks) { Cr = __builtin_amdgcn_mfma_f32_32x32x16_bf16(Af[ks], Br[ks], Cr, 0, 0, 0); Ci = __builtin_amdgcn_mfma_f32_32x32x16_bf16(Af[ks], Bi[ks], Ci, 0, 0, 0); }
        asm volatile("s_waitcnt lgkmcnt(0)" ::: "memory");
        float hl[16], P[16];
#pragma unroll
        for (int r = 0; r < 16; ++r) {
            const float xcv = XCS[crow(r, hi) * 33 + r32];
            const float rr = fast_sigmoid(Cr[r] + br), ii = fast_sigmoid(Ci[r] + bi);
            const float l2a = -Kc2 * rr;
            const float a = __builtin_amdgcn_exp2f(l2a);
            const float tt = 2.0f * 0.6931471805599453f * l2a;
            const float om = (tt > -0.25f) ? -tt * (1.0f + tt * (0.5f + tt * (0.16666667f + tt * (0.041666668f + tt * 0.008333334f)))) : 1.0f - a * a;
            P[r] = a; hl[r] = __builtin_amdgcn_sqrtf(fmaxf(om, 0.f)) * ii * xcv;
        }
#pragma unroll
        for (int g = 0; g < 4; ++g)
#pragma unroll
            for (int i = 1; i < 4; ++i) { hl[4 * g + i] = P[4 * g + i] * hl[4 * g + i - 1] + hl[4 * g + i]; P[4 * g + i] = P[4 * g + i] * P[4 * g + i - 1]; }
        float cown[4], qown[4]; float c = 0.f, q = 1.f;
#pragma unroll
        for (int g = 0; g < 4; ++g) {
            const float Ag = P[4 * g + 3], Hg = hl[4 * g + 3];
            const float oA = __shfl_xor(Ag, 32), oH = __shfl_xor(Hg, 32);
            const float A1 = hi ? oA : Ag, H1 = hi ? oH : Hg, A2 = hi ? Ag : oA, H2 = hi ? Hg : oH;
            const float c1 = A1 * c + H1, q1 = A1 * q;
            cown[g] = hi ? c1 : c; qown[g] = hi ? q1 : q;
            c = A2 * c1 + H2; q = A2 * q1;
        }
        if (hi == 0) SEG[(chunk & 1) * 256 + wave * 32 + r32] = (f32x2){q, c};
        __syncthreads();
        float cin = hc, my = 0.f;
#pragma unroll
        for (int w = 0; w < 8; ++w) { const f32x2 sg = SEG[(chunk & 1) * 256 + w * 32 + r32]; my = (w == wave) ? cin : my; cin = sg.x * cin + sg.y; }
        hc = cin;
#pragma unroll
        for (int r = 0; r < 16; ++r) {
            const int g = r >> 2; const float cg = cown[g] + qown[g] * my;
            const float y = (hl[r] + P[r] * cg) * bf2f(gq[r]);
            F.YAB[(orow0 + crow(r, hi)) * 2048 + ce + r32] = f2fp8(y);
        }
    }
}

__device__ __forceinline__ unsigned ord_key(float v) { const unsigned u = __float_as_uint(v); return u ^ ((unsigned)((int)u >> 31) | 0x80000000u); }
__device__ __forceinline__ void idx_unit(Frame& F, int b, int qi) {
    const int tid = F.tid, lane = F.lane, wave = F.wave, c = lane & 31, hi = lane >> 5;
    const int t0 = 16 * qi + 2 * wave, myt = t0 + hi;
    const size_t brow = (size_t)b * SEQ;
    bf16x8 Af[4];
    { const int q = (c >> 2) & 1, hh = (c & 3) + 4 * (c >> 3);
#pragma unroll
      for (int ks = 0; ks < 4; ++ks) Af[ks] = *(const bf16x8*)(F.IQ + (brow + t0 + q) * 1024 + hh * 64 + 8 * hi + 16 * ks); }
    float wv[16];
    { const u32x4 w0 = *(const u32x4*)(F.IW + (brow + myt) * 16), w1 = *(const u32x4*)(F.IW + (brow + myt) * 16 + 8);
      const float sc = 0.25f * 0.125f;
      wv[0] = bflo(w0.x) * sc; wv[1] = bfhi(w0.x) * sc; wv[2] = bflo(w0.y) * sc; wv[3] = bfhi(w0.y) * sc; wv[4] = bflo(w0.z) * sc; wv[5] = bfhi(w0.z) * sc; wv[6] = bflo(w0.w) * sc; wv[7] = bfhi(w0.w) * sc;
      wv[8] = bflo(w1.x) * sc; wv[9] = bfhi(w1.x) * sc; wv[10] = bflo(w1.y) * sc; wv[11] = bfhi(w1.y) * sc; wv[12] = bflo(w1.z) * sc; wv[13] = bfhi(w1.z) * sc; wv[14] = bflo(w1.w) * sc; wv[15] = bfhi(w1.w) * sc; }
    const int ntile = ((t0 + 1) >> 5) + 1;
    const int ntile_wg = ((16 * qi + 15) >> 5) + 1;
    int boff[4];
#pragma unroll
    for (int ks = 0; ks < 4; ++ks) boff[ks] = c * 128 + (((2 * ks + hi) ^ ((c >> 1) & 7)) << 4);
    unsigned keys[64];
#pragma unroll
    for (int j = 0; j < 64; ++j) keys[j] = 0u;
    unsigned isrc[8];
#pragma unroll
    for (int i = 0; i < 8; ++i) { const int row = (wave * 8 + i) * 8 + (lane >> 3), cpos = lane & 7; isrc[i] = (unsigned)(row * 128 + ((cpos ^ ((row >> 1) & 7)) << 4)); }
#define IDX_DMA(BUF, blk_) do { const char* kt_ = (const char*)(F.IK + (brow + (blk_) * 512) * 64); _Pragma("unroll") for (int i = 0; i < 8; ++i) { \
        unsigned io_ = isrc[i]; asm volatile("" : "+v"(io_)); \
        __builtin_amdgcn_global_load_lds((const unsigned*)(kt_ + io_), (LAS unsigned*)(F.lds + (BUF) * 65536 + (wave * 8 + i) * 1024), 16, 0, 0); } } while (0)
    IDX_DMA(0, 0);
#pragma unroll
    for (int blk = 0; blk < 4; ++blk) if (blk * 16 < ntile_wg) {
        asm volatile("s_waitcnt vmcnt(0)" ::: "memory"); __syncthreads();
        if ((blk + 1) * 16 < ntile_wg) { if (blk & 1) IDX_DMA(0, blk + 1); else IDX_DMA(1, blk + 1); }
#pragma unroll
        for (int jj = 0; jj < 16; ++jj) { const int j = blk * 16 + jj;
            if (j < ntile) {
                bf16x8 Bf[4];
#pragma unroll
                for (int ks = 0; ks < 4; ++ks) Bf[ks] = *(const LAS bf16x8*)(F.lds + (blk & 1) * 65536 + jj * 4096 + boff[ks]);
                f32x16 acc = {};
#pragma unroll
                for (int ks = 0; ks < 4; ++ks) acc = __builtin_amdgcn_mfma_f32_32x32x16_bf16(Af[ks], Bf[ks], acc, 0, 0, 0);
                float v = 0.f;
#pragma unroll
                for (int r = 0; r < 16; ++r) v += wv[r] * fmaxf(acc[r], 0.f);
                keys[j] = (32 * j + c <= myt) ? ord_key(v) : 0u;
            } }
    }
#undef IDX_DMA
    unsigned T = 1u;
    if (t0 >= 256) {
        T = 0u; bool done = false;
        for (int bit = 31; bit >= 0; --bit) {
            const unsigned cand = T | (1u << bit);
            int cnt = 0;
#pragma unroll
            for (int jb = 0; jb < 4; ++jb) if (jb * 16 < ntile) {
#pragma unroll
                for (int j = jb * 16; j < jb * 16 + 16; ++j) cnt += (keys[j] >= cand) ? 1 : 0; }
            cnt += __shfl_xor(cnt, 1); cnt += __shfl_xor(cnt, 2); cnt += __shfl_xor(cnt, 4); cnt += __shfl_xor(cnt, 8); cnt += __shfl_xor(cnt, 16);
            if (!done) { if (cnt >= 256) T = cand; if (cnt == 256) done = true; }
            if (__all(done)) break;
        }
    }
    int res0 = 0, res1 = 0;
#pragma unroll
    for (int jb = 0; jb < 4; ++jb) if (jb * 16 < ntile) {
#pragma unroll
        for (int j = jb * 16; j < jb * 16 + 16; ++j) {
            const unsigned long long bm = __ballot(keys[j] >= T);
            res0 = (lane == j) ? (int)(unsigned)bm : res0;
            res1 = (lane == j) ? (int)(unsigned)(bm >> 32) : res1;
        } }
    F.MASK[(brow + t0) * 64 + lane] = (unsigned)res0;
    F.MASK[(brow + t0 + 1) * 64 + lane] = (unsigned)res1;
}

#define KSWZ(row, colB) ((row) * 256 + ((colB) ^ (((row) & 7) << 4)))
__device__ __forceinline__ int v_st(int k, int c) { const int kk = (k & ~0xC) | ((k & 4) << 1) | ((k & 8) >> 1); return ((kk >> 3) * 4 + (c >> 5)) * 512 + ((kk & 7) * 32 + (c & 31)) * 2; }
__device__ __forceinline__ int v_rd_base(int lane) { return ((lane & 3) << 3) | (((lane >> 2) & 3) << 6) | (((lane >> 4) & 1) << 5) | (((lane >> 5) & 1) << 8); }
constexpr int v_rd_off(int d0, int ks, int half) { return d0 * 512 + ks * 4096 + half * 2048; }
constexpr int AT_K = 0, AT_V = 32768, AT_Q = 81920, AT_SCR = 147456;
static_assert(AT_Q + 8 * 8192 <= AT_SCR && AT_SCR + 2048 <= MISC_OFF, "attention LDS map");

__device__ __forceinline__ void attn_block(Frame& F, int b, int h, int qb) {
    const int lane = F.lane, wid = F.wave, r32 = lane & 31, hi = lane >> 5;
    LAS unsigned char* V_lds = F.lds + AT_V; LAS unsigned char* K_lds = F.lds + AT_K;
    LAS float* li_l = (LAS float*)(F.lds + AT_SCR) + wid * 64; LAS float* al_l = li_l + 32;
    const size_t brow = (size_t)b * SEQ;
    const bf16* Qp = F.QKV + (brow + qb * 256) * 3072 + h * 128;
    const bf16* Kp = F.QKV + brow * 3072 + 1024 + h * 128;
    const bf16* Vp = F.QKV + brow * 3072 + 2048 + h * 128;
    const int qpos = qb * 256 + wid * 32 + r32;
    const int qlast = qb * 256 + wid * 32 + 31;
    LAS unsigned char* Q_lds = F.lds + AT_Q + wid * 8192 + r32 * 256;
#pragma unroll
    for (int d0 = 0; d0 < 8; ++d0) *(LAS bf16x8*)(Q_lds + (((2 * d0 + hi) ^ (r32 & 15)) << 4)) = *(const bf16x8*)(Qp + (size_t)(wid * 32 + r32) * 3072 + d0 * 16 + hi * 8);
    const float slope2 = __builtin_amdgcn_exp2f(-(float)(h + 1)) * LOG2E;
    const unsigned* mrow = F.MASK + (brow + qpos) * 64;
    float m_reg = -1e30f, l_reg = 0.f; f32x16 o[4] = {};
    const int vb0 = (int)(unsigned)(uintptr_t)V_lds + v_rd_base(lane);
    const int nt = 4 * (qb + 1);
    unsigned ksrc[2], vsrc[2];
#pragma unroll
    for (int i = 0; i < 2; ++i) { const int sl = (wid * 2 + i) * 64 + lane;
        { const int row = sl >> 4, cpos = sl & 15; ksrc[i] = (unsigned)(row * 6144 + ((cpos ^ (row & 7)) << 4)); }
        { const int sub = sl >> 5, w = sl & 31, kk = (sub >> 2) * 8 + (w >> 2), k = (kk & ~0xC) | ((kk & 4) << 1) | ((kk & 8) >> 1), cc = (sub & 3) * 32 + (w & 3) * 8; vsrc[i] = (unsigned)(k * 6144 + cc * 2); } }
#define AT_DMA(KBUF, VBUF, kb_) do { const char* kt_ = (const char*)Kp + (size_t)(kb_) * 6144; const char* vt_ = (const char*)Vp + (size_t)(kb_) * 6144; _Pragma("unroll") for (int i = 0; i < 2; ++i) { \
        unsigned ko_ = ksrc[i], vo_ = vsrc[i]; asm volatile("" : "+v"(ko_), "+v"(vo_)); \
        __builtin_amdgcn_global_load_lds((const unsigned*)(kt_ + ko_), (LAS unsigned*)(K_lds + (KBUF) * 16384 + (wid * 2 + i) * 1024), 16, 0, 0); \
        __builtin_amdgcn_global_load_lds((const unsigned*)(vt_ + vo_), (LAS unsigned*)(V_lds + (VBUF) * 16384 + (wid * 2 + i) * 1024), 16, 0, 0); } } while (0)
#define AT_SYNC() do { asm volatile("s_waitcnt vmcnt(0)" ::: "memory"); __syncthreads(); } while (0)
#define PK4(P, B_, OUT) do { unsigned a0 = cvt_pk_bf16(P[B_+0], P[B_+1]), a1 = cvt_pk_bf16(P[B_+2], P[B_+3]);                          \
        unsigned b0 = cvt_pk_bf16(P[B_+4], P[B_+5]), b1 = cvt_pk_bf16(P[B_+6], P[B_+7]);                                             \
        auto r0 = __builtin_amdgcn_permlane32_swap(a0, b0, false, false); auto r1 = __builtin_amdgcn_permlane32_swap(a1, b1, false, false); \
        u32x4 w = {r0[0], r1[0], r0[1], r1[1]}; OUT = __builtin_bit_cast(bf16x8, w); } while (0)
#define TRRD(dst, off) asm volatile("ds_read_b64_tr_b16 %0, %1 offset:%2" : "=&v"(dst) : "v"(vbx), "i"(off) : "memory")
#define PV_D0(d0) do { s16x4 l0, l1, l2, l3, h0, h1, h2, h3; constexpr int b_ = v_rd_off(d0, 0, 0); \
        TRRD(l0, b_); TRRD(h0, b_ + 2048); TRRD(l1, b_ + 4096); TRRD(h1, b_ + 6144); TRRD(l2, b_ + 8192); TRRD(h2, b_ + 10240); TRRD(l3, b_ + 12288); TRRD(h3, b_ + 14336); \
        asm volatile("s_waitcnt lgkmcnt(0)" ::: "memory"); __builtin_amdgcn_sched_barrier(0);   \
        o[d0] = __builtin_amdgcn_mfma_f32_32x32x16_bf16(pa0, (bf16x8){l0[0], l0[1], l0[2], l0[3], h0[0], h0[1], h0[2], h0[3]}, o[d0], 0, 0, 0);   \
        o[d0] = __builtin_amdgcn_mfma_f32_32x32x16_bf16(pa1, (bf16x8){l1[0], l1[1], l1[2], l1[3], h1[0], h1[1], h1[2], h1[3]}, o[d0], 0, 0, 0);   \
        o[d0] = __builtin_amdgcn_mfma_f32_32x32x16_bf16(pa2, (bf16x8){l2[0], l2[1], l2[2], l2[3], h2[0], h2[1], h2[2], h2[3]}, o[d0], 0, 0, 0);   \
        o[d0] = __builtin_amdgcn_mfma_f32_32x32x16_bf16(pa3, (bf16x8){l3[0], l3[1], l3[2], l3[3], h3[0], h3[1], h3[2], h3[3]}, o[d0], 0, 0, 0); } while (0)
#define AT_PV(vbuf_) do { const int vbx = vb0 + (vbuf_) * 16384; PV_D0(0); PV_D0(1); PV_D0(2); PV_D0(3); } while (0)
#define AT_QKSM(kbuf_, t_) do { const int kb = (t_) * 64;                                                                          \
            f32x16 p0, p1;                                                                                                         \
            const float base = slope2 * (float)(kb + 4 * hi - qpos);                                                               \
            _Pragma("unroll") for (int r = 0; r < 16; ++r) { const float cr = (float)((r & 3) + 8 * (r >> 2)); p0[r] = base + slope2 * cr; p1[r] = base + slope2 * (cr + 32.f); } \
            _Pragma("unroll") for (int d0 = 0; d0 < 8; ++d0) {                                                                     \
                const int cB = ((d0 & 3) * 16 + hi * 8) * 2;                                                                       \
                const LAS unsigned char* a = K_lds + (kbuf_) * 16384 + KSWZ(r32, cB) + (d0 >> 2) * 128;                            \
                const bf16x8 b0 = *(const LAS bf16x8*)a, b1 = *(const LAS bf16x8*)(a + 32 * 256);                                  \
                const bf16x8 qd = *(const LAS bf16x8*)(Q_lds + (((2 * d0 + hi) ^ (r32 & 15)) << 4));                               \
                p0 = __builtin_amdgcn_mfma_f32_32x32x16_bf16(b0, qd, p0, 0, 0, 0);                                                 \
                p1 = __builtin_amdgcn_mfma_f32_32x32x16_bf16(b1, qd, p1, 0, 0, 0); }                                               \
            const unsigned w0 = mw.x >> (4 * hi), w1 = mw.y >> (4 * hi);                                                           \
            const float NEG = -__builtin_inff();                                                                                   \
            _Pragma("unroll") for (int r = 0; r < 16; ++r) { const int cr = (r & 3) + 8 * (r >> 2);                                \
                if (!((w0 >> cr) & 1u)) p0[r] = NEG;                                                                               \
                if (!((w1 >> cr) & 1u)) p1[r] = NEG; }                                                                             \
            float pmax = p0[0];                                                                                                    \
            _Pragma("unroll") for (int r = 1; r < 16; ++r) pmax = fmaxf(pmax, p0[r]);                                              \
            _Pragma("unroll") for (int r = 0; r < 16; ++r) pmax = fmaxf(pmax, p1[r]);                                              \
            { auto rr = __builtin_amdgcn_permlane32_swap(__float_as_uint(pmax), __float_as_uint(pmax), false, false);              \
              pmax = fmaxf(__uint_as_float(rr[0]), __uint_as_float(rr[1])); }                                                      \
            const float mn = fmaxf(m_reg, pmax);                                                                                   \
            const float alpha = __builtin_amdgcn_exp2f(m_reg - mn);                                                                \
            m_reg = mn;                                                                                                            \
            float ps = 0.f;                                                                                                        \
            _Pragma("unroll") for (int r = 0; r < 16; ++r) { p0[r] = __builtin_amdgcn_exp2f(p0[r] - mn); p1[r] = __builtin_amdgcn_exp2f(p1[r] - mn); ps += p0[r] + p1[r]; } \
            { auto rr = __builtin_amdgcn_permlane32_swap(__float_as_uint(ps), __float_as_uint(ps), false, false);                  \
              ps = __uint_as_float(rr[0]) + __uint_as_float(rr[1]); }                                                              \
            l_reg = l_reg * alpha + ps;                                                                                            \
            if (__any(alpha < 1.f)) {                            \
                if (hi == 0) al_l[r32] = alpha;                                                                                    \
                asm volatile("s_waitcnt lgkmcnt(0)" ::: "memory");                                                                 \
                _Pragma("unroll") for (int r = 0; r < 16; ++r) { const float al = al_l[crow(r, hi)];                               \
                    _Pragma("unroll") for (int d = 0; d < 4; ++d) o[d][r] *= al; } }                                               \
            PK4(p0, 0, pa0); PK4(p0, 8, pa1); PK4(p1, 0, pa2); PK4(p1, 8, pa3);                                                    \
        } while (0)
    const bool lag = wid >= 4;
    bf16x8 pa0, pa1, pa2, pa3; pa0 = pa1 = pa2 = pa3 = (bf16x8){0, 0, 0, 0, 0, 0, 0, 0};
    __syncthreads();
    AT_DMA(0, 0, 0);
    u32x2 mw; int vb3 = 0, pvb = 0; bool act_prev = false;
    for (int t = 0; t < nt; ++t) {
        AT_SYNC();
        mw = *(const u32x2*)(mrow + 2 * t);
        const int nvb = (vb3 == 2) ? 0 : vb3 + 1;
        if (t + 1 < nt) AT_DMA((t + 1) & 1, nvb, (t + 1) * 64);
        const bool act = t * 64 <= qlast;
        if (lag && act_prev) AT_PV(pvb);
        if (act) AT_QKSM(t & 1, t);
        if (!lag && act) AT_PV(vb3);
        act_prev = act; pvb = vb3; vb3 = nvb;
    }
    if (lag && act_prev) AT_PV(pvb);
#undef AT_DMA
#undef AT_SYNC
#undef AT_QKSM
#undef AT_PV
#undef PV_D0
#undef TRRD
#undef PK4
    if (hi == 0) li_l[r32] = l_reg;
    asm volatile("s_waitcnt lgkmcnt(0)" ::: "memory");
    unsigned char* Ow = F.YAB + (brow + qb * 256 + wid * 32) * 2048 + 1024 + h * 128;
#pragma unroll
    for (int r = 0; r < 16; ++r) { const int orow = crow(r, hi); const float rl = __builtin_amdgcn_rcpf(li_l[orow]);
#pragma unroll
        for (int d0 = 0; d0 < 4; ++d0) { const float v = o[d0][r] * rl; const float v1 = __shfl_xor(v, 1); const float v2 = __shfl_xor(v, 2), v3 = __shfl_xor(v1, 2);
            if ((r32 & 3) == 0) *(unsigned*)(Ow + (size_t)orow * 2048 + d0 * 32 + r32) = pk4_fp8(v, v1, v2, v3); } }
}

struct Args { const float* in[17]; float* out; unsigned char* ws; int ph_lo, ph_hi, li, pad; };
__global__ void __launch_bounds__(NWAVES * 64, 2) fwd(Args args) {
    extern __shared__ __attribute__((aligned(16))) unsigned char lds_raw[];
    Frame F;
    F.lds = (LAS unsigned char*)lds_raw;
    volatile LAS unsigned* MISC = (volatile LAS unsigned*)(F.lds + MISC_OFF);
    F.tid = threadIdx.x; F.lane = F.tid & 63; F.wave = __builtin_amdgcn_readfirstlane(F.tid >> 6);
    F.G = gridDim.x; { const int bx = blockIdx.x; F.vcu = (F.G % 8 == 0) ? (bx % 8) * (F.G / 8) + bx / 8 : bx; }
    unsigned char* ws = args.ws; F.ws = ws; F.ctl = (unsigned*)(ws + WS_CTL);
    F.x = args.in[0]; F.g_mix = args.in[1]; F.w_in = args.in[2]; F.conv_w = args.in[3]; F.conv_b = args.in[4]; F.w_rg_r = args.in[5]; F.b_rg_r = args.in[6];
    F.w_rg_i = args.in[7]; F.b_rg_i = args.in[8]; F.lam = args.in[9]; F.w_br_rnn = args.in[10]; F.w_br_attn = args.in[11]; F.w_out = args.in[12]; F.g_mlp = args.in[13];
    F.w_up = args.in[14]; F.w_dn = args.in[15]; F.g_fin = args.in[16]; F.out = args.out;
    F.WinT8 = ws + WS_WIN; F.WinTb = (bf16*)(ws + WS_WIN + 18 * MiB); F.WbrT = ws + WS_WBR; F.WoT = ws + WS_WO; F.WupT = ws + WS_WUP; F.WdnT = ws + WS_WDN;
    F.WrT = (bf16*)(ws + WS_WRT); F.WiT = (bf16*)(ws + WS_WRT + 131072);
    F.PA = (bf16*)(ws + WS_PA); F.QKV = (bf16*)(ws + WS_QKV); F.IQ = (bf16*)(ws + WS_IQ); F.IK = (bf16*)(ws + WS_IKW); F.IW = (bf16*)(ws + WS_IKW + 2 * MiB); F.GATES = (bf16*)(ws + WS_GATES);
    F.MIXED = ws + WS_MIXED; F.H1 = (bf16*)(ws + WS_H1); F.H2 = (bf16*)(ws + WS_H2); F.A2 = ws + WS_A2; F.ACT = ws + WS_ACT;
    F.XN = (bf16*)args.out; F.XN8 = (unsigned char*)args.out + 64 * MiB; F.YAB = (unsigned char*)args.out;
    F.MASK = (unsigned*)(ws + WS_MASK); F.TMP = (float*)(ws + WS_TMP); F.ssq1 = (float*)(F.ctl + CW_SSQ1); F.ssq2 = (float*)(F.ctl + CW_SSQ2);
    for (int u = F.tid; u < (LDS_BYTES - RING_BYTES) / 4; u += NWAVES * 64) ((LAS unsigned*)(F.lds + RING_BYTES))[u] = 0u;
    __syncthreads();
    XcdBarrier bar; bar.bar = F.ctl + CW_BAR; bar.x = 0; bar.st = nullptr;
    if (MK_N_LAUNCHES == 1) bar = xcd_barrier_post(F.ctl + CW_BAR + args.li * XCD_BAR_WORDS, MISC + 8);
#define GRID_BAR() do { if (MK_N_LAUNCHES == 1) xcd_barrier(bar); } while (0)
    const int lo = args.ph_lo, hi = args.ph_hi;
#ifndef PHASE_MASK
#define PHASE_MASK 0x1ff
#endif
#define IN(k) (((PHASE_MASK >> (k)) & 1) && lo <= (k) && (k) < hi)
#define BOTH(k) (IN(k) && IN((k) + 1))

    if (IN(0)) { p0_prologue(F); if (BOTH(0)) GRID_BAR(); }

    if (IN(1)) {
        { pg8::Gemm g{F.XN8, F.WinT8, 2048, 2048, 2048};
          EpiProj<0> E{F.PA, F.QKV, F.IQ, F.IK, F.IW, F.GATES};
          if (F.G == 256) { pg8::InprojOrder S; S.S.init(M, 9216, F.G, (int)blockIdx.x); pg8::gemm_phase<EpiProj<0>, pg8::InprojOrder, true>(F.lds, g, S, E); }
          else { pg8::StaticOrder S; S.init(M, 9216, F.G, (int)blockIdx.x); pg8::gemm_phase<EpiProj<0>, pg8::StaticOrder, true>(F.lds, g, S, E); } }
        __syncthreads();
        { pg8::Gemm g{F.XN, F.WinTb, 4096, 4096, 4096}; pg8::StaticOrder S; S.init(M, 1280, F.G, (int)blockIdx.x);
          EpiProj<1> E{F.PA, F.QKV, F.IQ, F.IK, F.IW, F.GATES};
          pg8::gemm_phase<EpiProj<1>, pg8::StaticOrder, false>(F.lds, g, S, E); }
        __syncthreads();
        if (LATE_TRANSPOSE) late_transposes(F, F.ctl + CW_LATEQ + 64 * args.li);
        if (BOTH(1)) GRID_BAR();
    }

    if (IN(2)) {
        for (int u = blockIdx.x; u < 128; u += F.G) { rnn_unit(F, u >> 4, u & 15, 0); rnn_unit(F, u >> 4, u & 15, 1); }
        volatile LAS unsigned* qslot = MISC + 16;
        for (;;) {
            __syncthreads();
            if (F.tid == 0) *qslot = __hip_atomic_fetch_add(F.ctl + CW_IDXQ + 64 * args.li, 1u, __ATOMIC_RELAXED, __HIP_MEMORY_SCOPE_AGENT);
            __syncthreads();
            const unsigned p = *qslot;
            if (p >= 1024u) break;
            const int uu = 1023 - (int)p;
            idx_unit(F, uu & 7, uu >> 3);
        }
        if (BOTH(2)) GRID_BAR();
    }

    if (IN(3)) {
        for (int p = blockIdx.x; p < 256; p += F.G) { const int bh = p >> 2, pr = p & 3;
            attn_block(F, bh >> 3, bh & 7, 7 - pr); attn_block(F, bh >> 3, bh & 7, pr); }
        if (BOTH(3)) GRID_BAR();
    }

    if (IN(4)) {
        pg8::Gemm g{F.YAB, F.WbrT, 1024, 2048, 2048}; pg8::PairOrder S; S.S.init(M, 2048, F.G, (int)blockIdx.x);
        EpiBranch E{F.GATES, F.MIXED};
        pg8::gemm_phase<EpiBranch, pg8::PairOrder, true>(F.lds, g, S, E);
        if (BOTH(4)) GRID_BAR();
    }

    if (IN(5)) {
        pg8::Gemm g{F.MIXED, F.WoT, 2048, 2048, 2048}; pg8::StaticOrder S; S.init(M, 2048, F.G, (int)blockIdx.x);
        EpiResid<true, false> E{F.x, F.H1, F.A2, F.ssq1, 1.0f / WO_SCALE};
        pg8::gemm_phase<EpiResid<true, false>, pg8::StaticOrder, true>(F.lds, g, S, E);
        if (BOTH(5)) GRID_BAR();
    }

    if (IN(6)) {
        pg8::Gemm g{F.A2, F.WupT, 2048, 2048, 2048}; pg8::StaticOrder S; S.init(M, DFF, F.G, (int)blockIdx.x);
        EpiUp E{F.ssq1, F.ACT};
        pg8::gemm_phase<EpiUp, pg8::StaticOrder, true>(F.lds, g, S, E);
        if (BOTH(6)) GRID_BAR();
    }

    if (IN(7)) {
        pg8::Gemm g{F.ACT, F.WdnT, 8192, 8192, 8192}; pg8::StaticOrder S; S.init(M, 2048, F.G, (int)blockIdx.x);
        EpiResid<false, true> E{F.H1, F.H2, nullptr, F.ssq2, 1.0f / WDN_SCALE};
        pg8::gemm_phase<EpiResid<false, true>, pg8::StaticOrder, true>(F.lds, g, S, E);
        if (BOTH(7)) GRID_BAR();
    }

    if (IN(8)) {
        const int gw = F.vcu * NWAVES + F.wave, NGW = F.G * NWAVES;
        f32x4 gv[8];
#pragma unroll
        for (int j = 0; j < 8; ++j) gv[j] = *((const f32x4*)F.g_fin + F.lane + 64 * j);
        for (int m = gw; m < M; m += NGW) {
            const float rstd = __builtin_amdgcn_rsqf(__hip_atomic_load(F.ssq2 + m, __ATOMIC_RELAXED, __HIP_MEMORY_SCOPE_AGENT) * (1.0f / D) + NORM_EPS);
            const u32x2* hr = (const u32x2*)(F.H2 + (size_t)m * D) + F.lane;
            f32x4* xr = (f32x4*)(F.out + (size_t)m * D) + F.lane;
            u32x2 hw[8];
#pragma unroll
            for (int j = 0; j < 8; ++j) hw[j] = hr[64 * j];
#pragma unroll
            for (int j = 0; j < 8; ++j) xr[64 * j] = (f32x4){bflo(hw[j].x), bfhi(hw[j].x), bflo(hw[j].y), bfhi(hw[j].y)} * rstd * gv[j];
        }
    }
#undef IN
#undef BOTH
#undef GRID_BAR
}

extern "C" void kernel_launch(void* const* d_in, const int* in_sizes, int n_in, void* d_out, int out_size, void* d_ws, size_t ws_size, hipStream_t stream) {
    static int grid = 0;
    if (grid == 0) {
        if (n_in != 17 || out_size != M * D || ws_size < WS_END) { fprintf(stderr, "kernel_launch: unexpected shapes (n_in %d, out %d, ws %zu)\n", n_in, out_size, ws_size); grid = -1; return; }
        int dev = 0, cus = 0, per_cu = 0;
        if (hipGetDevice(&dev) != hipSuccess || hipDeviceGetAttribute(&cus, hipDeviceAttributeMultiprocessorCount, dev) != hipSuccess) { grid = -1; return; }
        if (hipFuncSetAttribute((const void*)fwd, hipFuncAttributeMaxDynamicSharedMemorySize, LDS_BYTES) != hipSuccess) { fprintf(stderr, "kernel_launch: hipFuncSetAttribute failed\n"); grid = -1; return; }
        if (hipOccupancyMaxActiveBlocksPerMultiprocessor(&per_cu, (const void*)fwd, NWAVES * 64, LDS_BYTES) != hipSuccess || per_cu < 1)
            fprintf(stderr, "kernel_launch: occupancy query reports %d workgroups per CU\n", per_cu);
        (void)hipGetLastError();
        grid = cus;
    }
    if (grid < 0) return;
    if (hipMemsetAsync((char*)d_ws + WS_CTL, 0, CTL_ZERO_BYTES, stream) != hipSuccess) return;
    Args a{};
    for (int i = 0; i < 17; ++i) a.in[i] = (const float*)d_in[i];
    a.out = (float*)d_out; a.ws = (unsigned char*)d_ws; a.pad = 0;
    if (MK_N_LAUNCHES == 1 && PROBE_DUP >= 0) {
        a.ph_lo = 0; a.ph_hi = PROBE_DUP + 1; a.li = 0; hipLaunchKernelGGL(fwd, dim3(grid), dim3(NWAVES * 64), LDS_BYTES, stream, a);
        a.ph_lo = PROBE_DUP; a.ph_hi = PROBE_DUP + 1; a.li = 1; hipLaunchKernelGGL(fwd, dim3(grid), dim3(NWAVES * 64), LDS_BYTES, stream, a);
        if (PROBE_DUP + 1 < NPHASE) { a.ph_lo = PROBE_DUP + 1; a.ph_hi = NPHASE; a.li = 2; hipLaunchKernelGGL(fwd, dim3(grid), dim3(NWAVES * 64), LDS_BYTES, stream, a); }
    } else if (MK_N_LAUNCHES == 1) {
        a.ph_lo = 0; a.ph_hi = NPHASE; a.li = 0;
        hipLaunchKernelGGL(fwd, dim3(grid), dim3(NWAVES * 64), LDS_BYTES, stream, a);
    } else {
        for (int li = 0; li < NPHASE; ++li) { a.ph_lo = li; a.ph_hi = li + 1; a.li = li;
            hipLaunchKernelGGL(fwd, dim3(grid), dim3(NWAVES * 64), LDS_BYTES, stream, a); }
    }
}
```
